# Optimizing an MI355X kernel written in HIP

```python
import jax, jax.numpy as jnp
from jax import lax
import numpy as np

D_MODEL = 2048
BATCH = 2
SEQ = 4096
DEPTH = 4

N_MIXERS = 2
N_A_LAYERS = (DEPTH + N_MIXERS - 1) // N_MIXERS
N_B_LAYERS = DEPTH // N_MIXERS
HGRN_EXPAND = 128
HGRN_HEADS = D_MODEL // HGRN_EXPAND
HGRN_KEY_DIM = HGRN_HEADS * HGRN_EXPAND
HGRN_HEAD_V = D_MODEL // HGRN_HEADS
CHUNK = 64
CONV_WIDTH = 3
FFN_DIM = 5632
EPS = 1e-6

kernel_name = "bidir_hgrn2_shortconv_convffn_hybrid"


def rmsnorm(x, w):
    x32 = x.astype(jnp.float32)
    y = x32 * lax.rsqrt(jnp.mean(x32 * x32, axis=-1, keepdims=True) + EPS)
    return (y * w.astype(jnp.float32)).astype(x.dtype)


def dwconv3(z, w):
    L = z.shape[1]
    zp = jnp.pad(z, ((0, 0), (1, 1), (0, 0)))
    return w[0] * zp[:, :L] + w[1] * zp[:, 1:L + 1] + w[2] * zp[:, 2:]


def chunked_gated_recurrence(q, k, log_f, v):
    N, H, L, K = q.shape
    V = v.shape[-1]
    n_chunks = L // CHUNK

    def to_chunks(t):
        return t.reshape(N, H, n_chunks, CHUNK, t.shape[-1]).transpose(2, 0, 1, 3, 4)

    causal_in_chunk = jnp.tril(jnp.ones((CHUNK, CHUNK), dtype=bool))[:, :, None]

    def step(S, inp):
        qi, ki, gi, vi = inp
        b = jnp.cumsum(gi, axis=2)
        inter = jnp.einsum('nhtk,nhkv->nhtv', qi * jnp.exp(b), S)
        diff = b[:, :, :, None, :] - b[:, :, None, :, :]
        decay = jnp.exp(jnp.where(causal_in_chunk, diff, -jnp.inf))
        scores = jnp.einsum('nhtk,nhsk,nhtsk->nhts', qi, ki, decay)
        intra = jnp.einsum('nhts,nhsv->nhtv', scores, vi)
        b_last = b[:, :, -1]
        k_dec = ki * jnp.exp(b_last[:, :, None, :] - b)
        S_new = jnp.exp(b_last)[..., None] * S + jnp.einsum('nhck,nhcv->nhkv', k_dec, vi)
        return S_new, inter + intra

    S0 = jnp.zeros((N, H, K, V), jnp.float32)
    _, o = lax.scan(step, S0, (to_chunks(q), to_chunks(k), to_chunks(log_f), to_chunks(v)))
    return o.transpose(1, 2, 0, 3, 4).reshape(N, H, L, V)


def hgrn2_mixer(h, w_in, w_out, g_norm_w, lb_fwd, lb_bwd):
    B_, L, _ = h.shape
    K, D = HGRN_KEY_DIM, D_MODEL
    u = h @ w_in
    q, f_f, f_b, v, g = jnp.split(u, [K, 2 * K, 3 * K, 3 * K + D], axis=-1)
    q = jax.nn.silu(q)

    def gates(f_raw, lb):
        f = lb + (1.0 - lb) * jax.nn.sigmoid(f_raw.astype(jnp.float32))
        return 1.0 - f, jnp.log(f)

    k_f, lf_f = gates(f_f, lb_fwd)
    k_b, lf_b = gates(f_b, lb_bwd)

    def heads(t, d):
        return t.reshape(t.shape[0], L, HGRN_HEADS, d).transpose(0, 2, 1, 3).astype(jnp.float32)

    rev = lambda t: t[:, ::-1]
    qs = heads(jnp.concatenate([q, rev(q)], axis=0), HGRN_EXPAND)
    ks = heads(jnp.concatenate([k_f, rev(k_b)], axis=0), HGRN_EXPAND)
    ls = heads(jnp.concatenate([lf_f, rev(lf_b)], axis=0), HGRN_EXPAND)
    vs = heads(jnp.concatenate([v, rev(v)], axis=0), HGRN_HEAD_V)
    o = chunked_gated_recurrence(qs, ks, ls, vs)
    o = o[:B_] + o[B_:, :, ::-1]
    o = o.transpose(0, 2, 1, 3)
    gh = g.reshape(B_, L, HGRN_HEADS, HGRN_HEAD_V)
    o = rmsnorm(o, g_norm_w) * jax.nn.silu(gh.astype(jnp.float32))
    return o.reshape(B_, L, D).astype(h.dtype) @ w_out


def short_conv_mixer(h, w_in, w_conv, w_out):
    u = h @ w_in
    gate_b, gate_c, x_in = jnp.split(u, 3, axis=-1)
    z = dwconv3(gate_c * x_in, w_conv)
    return (gate_b * z) @ w_out


def conv_ffn(h, w_in, w_conv, w_out):
    up = dwconv3(h @ w_in, w_conv)
    gate, val = jnp.split(up, 2, axis=-1)
    return (jax.nn.silu(gate) * val) @ w_out


def setup_inputs(seed: int = 0) -> dict:
    key = jax.random.key(seed)
    ks = jax.random.split(key, 16)
    D, K, F = D_MODEL, HGRN_KEY_DIM, FFN_DIM
    nrm = lambda k, shape, scale: jax.random.normal(k, shape, jnp.float32) * scale
    return {
        "x": nrm(ks[0], (BATCH, SEQ, D), 1.0),
        "hgrn_w_in": nrm(ks[1], (N_A_LAYERS, D, 3 * K + 2 * D), D ** -0.5),
        "hgrn_w_out": nrm(ks[2], (N_A_LAYERS, D, D), D ** -0.5),
        "hgrn_gnorm": 1.0 + nrm(ks[3], (N_A_LAYERS, HGRN_HEAD_V), 0.02),
        "hgrn_lower_bounds": nrm(ks[4], (2, N_A_LAYERS, K), 1.0),
        "sconv_w_in": nrm(ks[5], (N_B_LAYERS, D, 3 * D), D ** -0.5),
        "sconv_w_conv": nrm(ks[6], (N_B_LAYERS, CONV_WIDTH, D), CONV_WIDTH ** -0.5),
        "sconv_w_out": nrm(ks[7], (N_B_LAYERS, D, D), D ** -0.5),
        "ffn_w_in": nrm(ks[8], (DEPTH, D, 2 * F), D ** -0.5),
        "ffn_w_conv": nrm(ks[9], (DEPTH, CONV_WIDTH, 2 * F), CONV_WIDTH ** -0.5),
        "ffn_w_out": nrm(ks[10], (DEPTH, F, D), F ** -0.5),
        "norm_pre_mix": 1.0 + nrm(ks[11], (DEPTH, D), 0.02),
        "norm_post_mix": 1.0 + nrm(ks[12], (DEPTH, D), 0.02),
        "norm_pre_ffn": 1.0 + nrm(ks[13], (DEPTH, D), 0.02),
        "norm_post_ffn": 1.0 + nrm(ks[14], (DEPTH, D), 0.02),
    }


def reference(x, hgrn_w_in, hgrn_w_out, hgrn_gnorm, hgrn_lower_bounds,
              sconv_w_in, sconv_w_conv, sconv_w_out,
              ffn_w_in, ffn_w_conv, ffn_w_out,
              norm_pre_mix, norm_post_mix, norm_pre_ffn, norm_post_ffn):
    lb = jnp.cumsum(jax.nn.softmax(hgrn_lower_bounds.astype(jnp.float32), axis=1), axis=1)
    lb = lb - lb[:, :1]
    for i in range(DEPTH):
        j = i // N_MIXERS
        h = rmsnorm(x, norm_pre_mix[i])
        if i % N_MIXERS == 0:
            m = hgrn2_mixer(h, hgrn_w_in[j], hgrn_w_out[j], hgrn_gnorm[j], lb[0, j], lb[1, j])
        else:
            m = short_conv_mixer(h, sconv_w_in[j], sconv_w_conv[j], sconv_w_out[j])
        x = x + rmsnorm(m, norm_post_mix[i])
        h = rmsnorm(x, norm_pre_ffn[i])
        x = x + rmsnorm(conv_ffn(h, ffn_w_in[i], ffn_w_conv[i], ffn_w_out[i]), norm_post_ffn[i])
    return x
```

```cpp
#include <hip/hip_runtime.h>
#include <hip/hip_cooperative_groups.h>
#include <cstdio>
#include <cstdint>
namespace cg = cooperative_groups;
namespace pg8 {
#define PG8_LAS __attribute__((address_space(3)))
typedef unsigned short bf16_t;
typedef short bf16x8 __attribute__((ext_vector_type(8)));
typedef float f32x4 __attribute__((ext_vector_type(4)));
typedef unsigned u32x4 __attribute__((ext_vector_type(4)));
constexpr int BM = 256, BK = 64, HALF = 128, HTB = HALF * BK * 2  , STAGE_BYTES = 8 * HTB, NXCD = 8, WGM = 8;

__host__ __device__ __forceinline__ int lds_byte(int r, int c) { const int st = (r >> 4) * 2 + (c >> 5), rr = r & 15, cc = c & 31, ob = rr * 64 + cc * 2; return st * 1024 + (ob ^ (((ob >> 9) & 1) << 5)); }
__host__ __device__ __forceinline__ void stage_rc(int b, int& R, int& C) { const int st = b / 1024, sb = b % 1024, swz = sb ^ (((sb >> 9) & 1) << 5); R = (st >> 1) * 16 + swz / 64; C = (st & 1) * 32 + (swz % 64) / 2; }
__host__ __device__ __forceinline__ int perm32(int rho) { const int n = rho >> 4, i = rho & 15; return 8 * (i >> 2) + 4 * n + (i & 3); }

struct Unit { int pm, pn; };
struct Gemm { const bf16_t* A; const bf16_t* Bt; int M, N, K; };

struct StaticOrder {
    int nM, nN, nwg, G, c;
    __host__ __device__ void init(int M, int N, int G_, int c_) { nM = M / BM; nN = N / BM; nwg = nM * nN; G = G_; c = c_; }
    __host__ __device__ bool next(int i, Unit& u) const {
        const long L = (long)i * G + c; if (L >= nwg) return false;
        int wgid = (int)L; { const int q = nwg / NXCD, r = nwg % NXCD, xcd = wgid % NXCD, off = wgid / NXCD; wgid = (xcd < r ? xcd * (q + 1) : r * (q + 1) + (xcd - r) * q) + off; }
        const int nig = WGM * nN, gid = wgid / nig, fm = gid * WGM, gsz = (nM - fm) < WGM ? (nM - fm) : WGM;
        u.pm = fm + ((wgid % nig) % gsz); u.pn = (wgid % nig) / gsz; return true;
    }
    __device__ __forceinline__ void a_ready(const Unit&) const {}
    __device__ __forceinline__ void done(const Unit&) const {}
};
__device__ __forceinline__ unsigned cvt_pk_bf16(float lo, float hi) { unsigned r; asm volatile("v_cvt_pk_bf16_f32 %0, %1, %2" : "=v"(r) : "v"(lo), "v"(hi)); return r; }
typedef float f32x2 __attribute__((ext_vector_type(2)));
template <class Epi, class Sched, bool ALIGN_EPI = false, bool SP2 = false>
__device__ __forceinline__ void gemm_phase(PG8_LAS unsigned char* lds, const Gemm g, const Sched& S, const Epi& E) {
    int tid_o = threadIdx.x; asm volatile("" : "+v"(tid_o));
    const int tid = tid_o, wid = __builtin_amdgcn_readfirstlane(tid >> 6), lane = tid & 63, wr = wid >> 2, wc = wid & 3, fr = lane & 15, fq = lane >> 4;
    const int K = g.K, nt = K / BK;
    unsigned voffA[2], voffB[2];
#pragma unroll
    for (int i = 0; i < 2; ++i) { int R, C; stage_rc(tid * 16 + i * 8192, R, C); const int Rb = Epi::PERM ? ((R & ~31) + perm32(R & 31)) : R;
        voffA[i] = (unsigned)(R * K + C) * 2u; voffB[i] = (unsigned)(Rb * K + C) * 2u; }
    const size_t kstep = (size_t)(BK * 2);
    const size_t hstep = (size_t)HALF * K * 2;
    const size_t tstep = 2 * hstep;
    const unsigned ldsw = (unsigned)wid * 1024u;
    const int aoff = lds_byte(wr * 64 + fr, fq * 8), boff = lds_byte(wc * 32 + fr, fq * 8);
#define PG8_SA(b, h) (((b) * 2 + (h)) * HTB)
#define PG8_SB(b, h) ((4 + (b) * 2 + (h)) * HTB)
#define PG8_STAGE(bufoff, gbase, voff) do { _Pragma("unroll") for (int _i = 0; _i < 2; ++_i) \
        __builtin_amdgcn_global_load_lds((const unsigned*)((const char*)(gbase) + (voff)[_i]), (PG8_LAS unsigned*)(lds + (bufoff) + ldsw + _i * 8192), 16, 0, 0); } while (0)
#define PG8_LDA(dst, b, h) do { _Pragma("unroll") for (int m = 0; m < 4; ++m) _Pragma("unroll") for (int k = 0; k < 2; ++k) dst[m][k] = *(const PG8_LAS bf16x8*)(lds + PG8_SA(b, h) + aoff + m * 2048 + k * 1024); } while (0)
#define PG8_LDB(dst, b, h) do { _Pragma("unroll") for (int n = 0; n < 2; ++n) _Pragma("unroll") for (int k = 0; k < 2; ++k) dst[n][k] = *(const PG8_LAS bf16x8*)(lds + PG8_SB(b, h) + boff + n * 2048 + k * 1024); } while (0)
#define PG8_MMA(ai, bj, At, Bt) do { __builtin_amdgcn_s_setprio(1); _Pragma("unroll") for (int m = 0; m < 4; ++m) _Pragma("unroll") for (int n = 0; n < 2; ++n) _Pragma("unroll") for (int k = 0; k < 2; ++k) \
        acc[ai][bj][m][n] = __builtin_amdgcn_mfma_f32_16x16x32_bf16(Bt[n][k], At[m][k], acc[ai][bj][m][n], 0, 0, 0); __builtin_amdgcn_s_setprio(0); } while (0)
#define PG8_WAIT_V(n) asm volatile("s_waitcnt vmcnt(" #n ")" ::: "memory")
#define PG8_WAIT_L(n) asm volatile("s_waitcnt lgkmcnt(" #n ")" ::: "memory")
#define PG8_BAR __builtin_amdgcn_s_barrier()
#define PG8_SCHED __builtin_amdgcn_sched_barrier(0)
    Unit cur, nxt; int ui = 0;
    if (!S.next(0, cur)) return;
    f32x4 acc[2][2][4][2];
#pragma unroll
    for (int a = 0; a < 2; ++a)
#pragma unroll
        for (int b = 0; b < 2; ++b)
#pragma unroll
            for (int m = 0; m < 4; ++m)
#pragma unroll
                for (int n = 0; n < 2; ++n) acc[a][b][m][n] = (f32x4){0.f, 0.f, 0.f, 0.f};
    bf16x8 At[4][2], B0[2][2], B1[2][2];
    const char* cA = (const char*)g.A + (size_t)cur.pm * tstep; const char* cB = (const char*)g.Bt + (size_t)cur.pn * tstep;
    S.a_ready(cur);
    if constexpr (SP2) {
        PG8_STAGE(PG8_SB(0, 0), cB, voffB); PG8_STAGE(PG8_SB(0, 1), cB + hstep, voffB); PG8_STAGE(PG8_SA(0, 0), cA, voffA); PG8_STAGE(PG8_SA(0, 1), cA + hstep, voffA);
        if (wr == 1) PG8_BAR;
        PG8_WAIT_V(2); PG8_BAR;
        PG8_STAGE(PG8_SB(1, 0), cB + kstep, voffB); PG8_STAGE(PG8_SA(1, 0), cA + kstep, voffA); PG8_STAGE(PG8_SB(1, 1), cB + hstep + kstep, voffB);
        PG8_WAIT_V(6); PG8_BAR;
    } else {
        PG8_STAGE(PG8_SB(0, 0), cB, voffB); PG8_STAGE(PG8_SA(0, 0), cA, voffA); PG8_STAGE(PG8_SB(0, 1), cB + hstep, voffB); PG8_STAGE(PG8_SA(0, 1), cA + hstep, voffA);
        if (wr == 1) PG8_BAR;
        PG8_WAIT_V(4); PG8_BAR;
        PG8_STAGE(PG8_SB(1, 0), cB + kstep, voffB); PG8_STAGE(PG8_SA(1, 0), cA + kstep, voffA); PG8_STAGE(PG8_SB(1, 1), cB + hstep + kstep, voffB);
        PG8_WAIT_V(6); PG8_BAR;
    }
    for (;;) {
        const bool has_next = S.next(ui + 1, nxt);
        const char* nA = has_next ? (const char*)g.A + (size_t)nxt.pm * tstep : cA; const char* nB = has_next ? (const char*)g.Bt + (size_t)nxt.pn * tstep : cB;
        for (int t = 0; t < nt; t += 2) {
            const bool last = (t == nt - 2);
            const char* a1 = cA + (size_t)(t + 1) * kstep;
            const char* a2 = last ? nA : cA + (size_t)(t + 2) * kstep; const char* b2 = last ? nB : cB + (size_t)(t + 2) * kstep;
            const char* a3 = a2 + kstep; const char* b3 = b2 + kstep;
            if (last && has_next) S.a_ready(nxt);
            if constexpr (SP2) {
            PG8_LDB(B0, 0, 0); PG8_LDB(B1, 0, 1); PG8_SCHED; PG8_LDA(At, 0, 0); PG8_STAGE(PG8_SA(1, 1), a1 + hstep, voffA);
            PG8_WAIT_V(8); PG8_WAIT_L(0); PG8_BAR; PG8_MMA(0, 0, At, B0); PG8_MMA(0, 1, At, B1); PG8_BAR; PG8_SCHED;
            PG8_LDA(At, 0, 1); PG8_STAGE(PG8_SB(0, 0), b2, voffB); PG8_STAGE(PG8_SB(0, 1), b2 + hstep, voffB); PG8_STAGE(PG8_SA(0, 0), a2, voffA);
            PG8_WAIT_V(8); PG8_WAIT_L(0); PG8_BAR; PG8_MMA(1, 0, At, B0); PG8_MMA(1, 1, At, B1); PG8_BAR; PG8_SCHED;
            PG8_LDB(B0, 1, 0); PG8_LDB(B1, 1, 1); PG8_SCHED; PG8_LDA(At, 1, 0); PG8_STAGE(PG8_SA(0, 1), a2 + hstep, voffA);
            PG8_WAIT_V(8); PG8_WAIT_L(0); PG8_BAR; PG8_MMA(0, 0, At, B0); PG8_MMA(0, 1, At, B1); PG8_BAR; PG8_SCHED;
            PG8_LDA(At, 1, 1); PG8_STAGE(PG8_SB(1, 0), b3, voffB); PG8_STAGE(PG8_SB(1, 1), b3 + hstep, voffB); PG8_STAGE(PG8_SA(1, 0), a3, voffA);
            PG8_WAIT_V(8); PG8_WAIT_L(0); PG8_BAR; PG8_MMA(1, 0, At, B0); PG8_MMA(1, 1, At, B1); PG8_BAR; PG8_SCHED;
            } else {
            PG8_LDB(B0, 0, 0); PG8_SCHED; PG8_LDA(At, 0, 0); PG8_STAGE(PG8_SA(1, 1), a1 + hstep, voffA);
            PG8_WAIT_L(8); PG8_BAR; PG8_WAIT_L(0); PG8_MMA(0, 0, At, B0); PG8_BAR; PG8_SCHED;
            PG8_LDB(B1, 0, 1); PG8_STAGE(PG8_SB(0, 0), b2, voffB);
            PG8_BAR; PG8_WAIT_L(0); PG8_MMA(0, 1, At, B1); PG8_BAR;
            PG8_LDA(At, 0, 1); PG8_STAGE(PG8_SA(0, 0), a2, voffA);
            PG8_BAR; PG8_WAIT_L(0); PG8_MMA(1, 0, At, B0); PG8_BAR; PG8_SCHED;
            PG8_STAGE(PG8_SB(0, 1), b2 + hstep, voffB);
            PG8_WAIT_V(6); PG8_BAR; PG8_MMA(1, 1, At, B1); PG8_BAR;
            PG8_LDB(B0, 1, 0); PG8_SCHED; PG8_LDA(At, 1, 0); PG8_STAGE(PG8_SA(0, 1), a2 + hstep, voffA);
            PG8_WAIT_L(8); PG8_BAR; PG8_WAIT_L(0); PG8_MMA(0, 0, At, B0); PG8_BAR; PG8_SCHED;
            PG8_LDB(B1, 1, 1); PG8_STAGE(PG8_SB(1, 0), b3, voffB);
            PG8_BAR; PG8_WAIT_L(0); PG8_MMA(0, 1, At, B1); PG8_BAR;
            PG8_LDA(At, 1, 1); PG8_STAGE(PG8_SA(1, 0), a3, voffA);
            PG8_BAR; PG8_WAIT_L(0); PG8_MMA(1, 0, At, B0); PG8_BAR; PG8_SCHED;
            PG8_STAGE(PG8_SB(1, 1), b3 + hstep, voffB);
            PG8_WAIT_V(6); PG8_BAR; PG8_MMA(1, 1, At, B1); PG8_BAR;
            }
        }
        if constexpr (ALIGN_EPI) { if (wr == 0) PG8_BAR; }
        if constexpr (!Epi::AFTER_DRAIN) { E(acc, cur, wr, wc, fr, fq); S.done(cur); }
        if (!has_next) break;
#pragma unroll
        for (int a = 0; a < 2; ++a)
#pragma unroll
            for (int b = 0; b < 2; ++b)
#pragma unroll
                for (int m = 0; m < 4; ++m)
#pragma unroll
                    for (int n = 0; n < 2; ++n) acc[a][b][m][n] = (f32x4){0.f, 0.f, 0.f, 0.f};
        cur = nxt; cA = nA; cB = nB; ++ui;
        if constexpr (ALIGN_EPI) { if (wr == 1) PG8_BAR; }
    }
    PG8_WAIT_V(0);
    if constexpr (!ALIGN_EPI) { if (wr == 0) PG8_BAR; }
    PG8_BAR;
    if constexpr (Epi::AFTER_DRAIN) { E.fused(acc, cur, wr, wc, fr, fq, lds, wid, lane); S.done(cur); }
#undef PG8_SA
#undef PG8_SB
#undef PG8_STAGE
#undef PG8_LDA
#undef PG8_LDB
#undef PG8_MMA
#undef PG8_WAIT_V
#undef PG8_WAIT_L
#undef PG8_BAR
#undef PG8_SCHED
}
}
namespace pg8 {
__device__ __forceinline__ float fsigmoid(float x) { return __builtin_amdgcn_rcpf(1.0f + __expf(-x)); }
struct EpiF32 {
    static constexpr bool PERM = false, AFTER_DRAIN = false;
    float* C; int ldc;
    __device__ __forceinline__ void operator()(const f32x4 (&acc)[2][2][4][2], const Unit& u, int wr, int wc, int fr, int fq) const {
        const int row0 = u.pm * BM + wr * 64 + fr, col0 = u.pn * BM + wc * 32 + 4 * fq;
#pragma unroll
        for (int ai = 0; ai < 2; ++ai)
#pragma unroll
            for (int m = 0; m < 4; ++m) { float* rowp = C + (size_t)(row0 + ai * HALF + m * 16) * ldc + col0;
#pragma unroll
                for (int bj = 0; bj < 2; ++bj)
#pragma unroll
                    for (int n = 0; n < 2; ++n) *(f32x4*)(rowp + bj * HALF + n * 16) = acc[ai][bj][m][n]; }
    }
};
struct EpiBf16 {
    static constexpr bool PERM = true, AFTER_DRAIN = false;
    bf16_t* O; int ldc;
    __device__ __forceinline__ void operator()(const f32x4 (&acc)[2][2][4][2], const Unit& u, int wr, int wc, int fr, int fq) const {
        const int row0 = u.pm * BM + wr * 64 + fr, col0 = u.pn * BM + wc * 32 + 8 * fq;
#pragma unroll
        for (int ai = 0; ai < 2; ++ai)
#pragma unroll
            for (int m = 0; m < 4; ++m) { bf16_t* rowp = O + (size_t)(row0 + ai * HALF + m * 16) * ldc + col0;
#pragma unroll
                for (int bj = 0; bj < 2; ++bj) { const f32x4 v0 = acc[ai][bj][m][0], v1 = acc[ai][bj][m][1];
                    u32x4 w; w.x = cvt_pk_bf16(v0[0], v0[1]); w.y = cvt_pk_bf16(v0[2], v0[3]); w.z = cvt_pk_bf16(v1[0], v1[1]); w.w = cvt_pk_bf16(v1[2], v1[3]);
                    *(u32x4*)(rowp + bj * HALF) = w; } }
    }
};
struct EpiHgrn {
    static constexpr bool PERM = true, AFTER_DRAIN = false;
    unsigned char* Ub; const float* lbs; int layer_j;
    __device__ __forceinline__ void operator()(const f32x4 (&acc)[2][2][4][2], const Unit& u, int wr, int wc, int fr, int fq) const {
        const int seg = u.pn >> 3, colt = (u.pn & 7) * BM;
        const int row0 = u.pm * BM + wr * 64 + fr, col0 = colt + wc * 32 + 8 * fq;
        if (seg == 1 || seg == 2) {
            const int dir = seg - 1; float* LF = (float*)(Ub + ((size_t)(96 + 64 * dir) << 20));
#pragma unroll
            for (int bj = 0; bj < 2; ++bj) {
                float lb[8];
#pragma unroll
                for (int e = 0; e < 8; ++e) lb[e] = 0.f;
                if (layer_j == 1) {
                    const f32x4 a0 = *(const f32x4*)(lbs + (size_t)(dir * 2 + 0) * 2048 + col0 + bj * HALF), a1 = *(const f32x4*)(lbs + (size_t)(dir * 2 + 0) * 2048 + col0 + bj * HALF + 4);
                    const f32x4 b0 = *(const f32x4*)(lbs + (size_t)(dir * 2 + 1) * 2048 + col0 + bj * HALF), b1 = *(const f32x4*)(lbs + (size_t)(dir * 2 + 1) * 2048 + col0 + bj * HALF + 4);
#pragma unroll
                    for (int e = 0; e < 4; ++e) { lb[e] = fsigmoid(b0[e] - a0[e]); lb[4 + e] = fsigmoid(b1[e] - a1[e]); }
                }
#pragma unroll
                for (int ai = 0; ai < 2; ++ai)
#pragma unroll
                    for (int m = 0; m < 4; ++m) { float* rowp = LF + (size_t)(row0 + ai * HALF + m * 16) * 2048 + col0 + bj * HALF;
#pragma unroll
                        for (int n = 0; n < 2; ++n) { f32x4 o;
#pragma unroll
                            for (int e = 0; e < 4; ++e) { const float s = fsigmoid(acc[ai][bj][m][n][e]); const float l = lb[4 * n + e]; o[e] = __logf(l + (1.0f - l) * s); }
                            *(f32x4*)(rowp + 4 * n) = o; } }
            }
        } else {
            const int sel = (seg == 0) ? 0 : ((seg == 3) ? 1 : 2); bf16_t* O = (bf16_t*)(Ub + ((size_t)(32 * sel) << 20)); const bool act = (seg != 3);
#pragma unroll
            for (int ai = 0; ai < 2; ++ai)
#pragma unroll
                for (int m = 0; m < 4; ++m) { bf16_t* rowp = O + (size_t)(row0 + ai * HALF + m * 16) * 2048 + col0;
#pragma unroll
                    for (int bj = 0; bj < 2; ++bj) { f32x4 v0 = acc[ai][bj][m][0], v1 = acc[ai][bj][m][1];
                        if (act) {
#pragma unroll
                            for (int e = 0; e < 4; ++e) { v0[e] = v0[e] * fsigmoid(v0[e]); v1[e] = v1[e] * fsigmoid(v1[e]); } }
                        u32x4 w; w.x = cvt_pk_bf16(v0[0], v0[1]); w.y = cvt_pk_bf16(v0[2], v0[3]); w.z = cvt_pk_bf16(v1[0], v1[1]); w.w = cvt_pk_bf16(v1[2], v1[3]);
                        *(u32x4*)(rowp + bj * HALF) = w; } }
        }
    }
};
}
#define GAS __attribute__((address_space(1)))
#define LAS __attribute__((address_space(3)))
typedef unsigned short bf16;
typedef unsigned v4u __attribute__((ext_vector_type(4)));
typedef unsigned v2u __attribute__((ext_vector_type(2)));
typedef float f32x4 __attribute__((ext_vector_type(4)));
typedef short bf16x8 __attribute__((ext_vector_type(8)));
constexpr int NWAVES = 8, NTHR = 512;
constexpr int D = 2048, BATCH = 2, SEQ = 4096, M = BATCH * SEQ, DEPTH = 4, NH = 16, HK = 128, FF = 5632;
constexpr int N_HG = 5 * D, N_SC = 3 * D, N_FI = 2 * FF;
constexpr float EPS = 1e-6f;
constexpr size_t MiB = 1u << 20;
constexpr size_t WS_CTL = 0, WS_WHGI = 2 * MiB, WS_WHGO = 82 * MiB, WS_WSCI = 98 * MiB, WS_WSCO = 146 * MiB, WS_WFI = 162 * MiB, WS_WFO = 338 * MiB;
constexpr size_t WS_X = 426 * MiB, WS_XN = 490 * MiB, WS_MBUF = 522 * MiB, WS_U = 586 * MiB, WS_ACT = 810 * MiB, WS_REC = 898 * MiB, WS_END = 1284 * MiB;
constexpr size_t U_Q = 0, U_V = 32 * MiB, U_G = 64 * MiB, U_LFF = 96 * MiB, U_LFB = 160 * MiB;
constexpr int LDS_BYTES = 147456;

__device__ __forceinline__ unsigned f2bf(float f) { unsigned u = __builtin_bit_cast(unsigned, f); return (u + 0x7fffu + ((u >> 16) & 1u)) >> 16; }
__device__ __forceinline__ unsigned pk2(float lo, float hi) { return f2bf(lo) | (f2bf(hi) << 16); }
__device__ __forceinline__ float bflo(unsigned w) { return __builtin_bit_cast(float, w << 16); }
__device__ __forceinline__ float bfhi(unsigned w) { return __builtin_bit_cast(float, w & 0xffff0000u); }
__device__ __forceinline__ float bf2f(bf16 b) { return __builtin_bit_cast(float, ((unsigned)b) << 16); }
__device__ __forceinline__ float wave_sum(float v) {
#pragma unroll
    for (int o = 1; o < 64; o <<= 1) v += __shfl_xor(v, o);
    return v;
}
__device__ __forceinline__ float fsig(float x) { return __builtin_amdgcn_rcpf(1.0f + __expf(-x)); }
#define LDS_WAIT() asm volatile("s_waitcnt lgkmcnt(0)" ::: "memory")

__device__ __forceinline__ void p0_transpose_item(const float* W, int K, int N, bf16* WT, LAS float* scr, int item, int lane) {
    const int nblk = N / 32, kb = item / nblk, nb = item % nblk, k0 = 64 * kb, n0 = 32 * nb;
#pragma unroll 8
    for (int i = 0; i < 32; ++i) { const int kk = 2 * i + (lane >> 5); scr[kk * 33 + (lane & 31)] = W[(size_t)(k0 + kk) * N + n0 + (lane & 31)]; }
    LDS_WAIT(); asm volatile("" ::: "memory");
    const int c = lane & 7;
#pragma unroll
    for (int j = 0; j < 4; ++j) { const int n = (lane >> 3) + 8 * j; const LAS float* s = scr + (8 * c) * 33 + n;
        v4u o; o.x = pk2(s[0 * 33], s[1 * 33]); o.y = pk2(s[2 * 33], s[3 * 33]); o.z = pk2(s[4 * 33], s[5 * 33]); o.w = pk2(s[6 * 33], s[7 * 33]);
        *(v4u*)(WT + (size_t)(n0 + n) * K + k0 + 8 * c) = o; }
    LDS_WAIT(); asm volatile("" ::: "memory");
}
__device__ __forceinline__ void transpose_matrix(const float* W, int K, int N, bf16* WT, LAS float* scr, int gw, int NGW, int lane) {
    const int items = (K / 64) * (N / 32);
    for (int it = gw; it < items; it += NGW) p0_transpose_item(W, K, N, WT, scr, it, lane);
}

__device__ __forceinline__ void rownorm_phase(const float* xin, const float* mb, const float* w_post, const float* w_next, float* xout, bf16* xn, int gw, int NGW, int lane) {
    for (int m = gw; m < M; m += NGW) {
        const f32x4* xr = (const f32x4*)(xin + (size_t)m * D) + lane;
        f32x4 x[8];
#pragma unroll
        for (int j = 0; j < 8; ++j) x[j] = xr[64 * j];
        if (mb) {
            const f32x4* mr = (const f32x4*)(mb + (size_t)m * D) + lane;
            f32x4 mm[8]; float ss = 0.f;
#pragma unroll
            for (int j = 0; j < 8; ++j) { mm[j] = mr[64 * j]; ss += (mm[j].x * mm[j].x + mm[j].y * mm[j].y) + (mm[j].z * mm[j].z + mm[j].w * mm[j].w); }
            const float rstd = __builtin_amdgcn_rsqf(wave_sum(ss) * (1.f / D) + EPS);
#pragma unroll
            for (int j = 0; j < 8; ++j) { const f32x4 w = ((const f32x4*)w_post)[lane + 64 * j]; x[j] = x[j] + mm[j] * rstd * w; }
        }
        if (xout) { f32x4* o = (f32x4*)(xout + (size_t)m * D) + lane;
#pragma unroll
            for (int j = 0; j < 8; ++j) o[64 * j] = x[j]; }
        if (xn) {
            float s2 = 0.f;
#pragma unroll
            for (int j = 0; j < 8; ++j) s2 += (x[j].x * x[j].x + x[j].y * x[j].y) + (x[j].z * x[j].z + x[j].w * x[j].w);
            const float r2 = __builtin_amdgcn_rsqf(wave_sum(s2) * (1.f / D) + EPS);
            v2u* o8 = (v2u*)(xn + (size_t)m * D) + lane;
#pragma unroll
            for (int j = 0; j < 8; ++j) { const f32x4 w = ((const f32x4*)w_next)[lane + 64 * j]; v2u o; o.x = pk2(x[j].x * r2 * w.x, x[j].y * r2 * w.y); o.y = pk2(x[j].z * r2 * w.z, x[j].w * r2 * w.w); o8[64 * j] = o; }
        }
    }
}

__device__ __forceinline__ void rec_naive_phase(const bf16* Q, const bf16* V, const float* LFf, const float* LFb, float* Of, float* Ob, int gw, int NGW, int lane) {
    const int kg = lane >> 3, vv = lane & 7;
    for (int task = gw; task < 1024; task += NGW) {
        const int dir = task >> 9, b = (task >> 8) & 1, h = (task >> 4) & 15, vs = task & 15;
        const float* lf = (dir ? LFb : LFf) + (size_t)b * SEQ * D + h * HK + kg * 16;
        const bf16* q = Q + (size_t)b * SEQ * D + h * HK + kg * 16;
        const bf16* v = V + (size_t)b * SEQ * D + h * HK + vs * 8 + vv;
        float* o = (dir ? Ob : Of) + (size_t)b * SEQ * D + h * HK + vs * 8 + vv;
        float S[16];
#pragma unroll
        for (int e = 0; e < 16; ++e) S[e] = 0.f;
#pragma unroll 2
        for (int step = 0; step < SEQ; ++step) {
            const int t = dir ? (SEQ - 1 - step) : step;
            const f32x4* lp = (const f32x4*)(lf + (size_t)t * D);
            const v4u* qp = (const v4u*)(q + (size_t)t * D);
            const f32x4 l0 = lp[0], l1 = lp[1], l2 = lp[2], l3 = lp[3];
            const v4u q0 = qp[0], q1 = qp[1];
            const float vval = bf2f(v[(size_t)t * D]);
            float lfv[16] = {l0.x, l0.y, l0.z, l0.w, l1.x, l1.y, l1.z, l1.w, l2.x, l2.y, l2.z, l2.w, l3.x, l3.y, l3.z, l3.w};
            float qv[16] = {bflo(q0.x), bfhi(q0.x), bflo(q0.y), bfhi(q0.y), bflo(q0.z), bfhi(q0.z), bflo(q0.w), bfhi(q0.w), bflo(q1.x), bfhi(q1.x), bflo(q1.y), bfhi(q1.y), bflo(q1.z), bfhi(q1.z), bflo(q1.w), bfhi(q1.w)};
            float dot = 0.f;
#pragma unroll
            for (int e = 0; e < 16; ++e) { const float f = __expf(lfv[e]); S[e] = f * S[e] + (1.0f - f) * vval; dot += S[e] * qv[e]; }
            dot += __shfl_xor(dot, 8); dot += __shfl_xor(dot, 16); dot += __shfl_xor(dot, 32);
            if (kg == 0) o[(size_t)t * D] = dot;
        }
    }
}

__device__ __forceinline__ void gate_phase(const float* Of, const float* Ob, const bf16* G, const float* gnw, bf16* Y, int gw, int NGW, int lane) {
    const f32x4 w = ((const f32x4*)gnw)[lane & 31];
    for (int m = gw; m < M; m += NGW) {
        const f32x4* a = (const f32x4*)(Of + (size_t)m * D) + lane; const f32x4* b = (const f32x4*)(Ob + (size_t)m * D) + lane;
        const v2u* g = (const v2u*)(G + (size_t)m * D) + lane; v2u* y = (v2u*)(Y + (size_t)m * D) + lane;
#pragma unroll
        for (int j = 0; j < 8; ++j) {
            const f32x4 o = a[64 * j] + b[64 * j]; const v2u gg = g[64 * j];
            float ss = (o.x * o.x + o.y * o.y) + (o.z * o.z + o.w * o.w);
            ss += __shfl_xor(ss, 1); ss += __shfl_xor(ss, 2); ss += __shfl_xor(ss, 4); ss += __shfl_xor(ss, 8); ss += __shfl_xor(ss, 16);
            const float r = __builtin_amdgcn_rsqf(ss * (1.f / HK) + EPS);
            v2u out; out.x = pk2(o.x * r * w.x * bflo(gg.x), o.y * r * w.y * bfhi(gg.x)); out.y = pk2(o.z * r * w.z * bflo(gg.y), o.w * r * w.w * bfhi(gg.y));
            y[64 * j] = out;
        }
    }
}

__device__ __forceinline__ void unpack8(const v4u a, float (&f)[8]) { f[0] = bflo(a.x); f[1] = bfhi(a.x); f[2] = bflo(a.y); f[3] = bfhi(a.y); f[4] = bflo(a.z); f[5] = bfhi(a.z); f[6] = bflo(a.w); f[7] = bfhi(a.w); }
__device__ __forceinline__ v4u pack8(const float (&f)[8]) { v4u o; o.x = pk2(f[0], f[1]); o.y = pk2(f[2], f[3]); o.z = pk2(f[4], f[5]); o.w = pk2(f[6], f[7]); return o; }

__device__ __forceinline__ void sconv_phase(const bf16* U, const float* wc, bf16* Y, int gtid, int NT) {
    for (int idx = gtid; idx < M * (D / 8); idx += NT) {
        const int m = idx >> 8, c0 = (idx & 255) * 8, tp = m & (SEQ - 1);
        float w0[8], w1[8], w2[8];
#pragma unroll
        for (int e = 0; e < 8; ++e) { w0[e] = wc[c0 + e]; w1[e] = wc[D + c0 + e]; w2[e] = wc[2 * D + c0 + e]; }
        const bf16* r = U + (size_t)m * N_SC + c0;
        float gb[8], c[8], x[8], z[8];
        unpack8(*(const v4u*)(r), gb); unpack8(*(const v4u*)(r + D), c); unpack8(*(const v4u*)(r + 2 * D), x);
#pragma unroll
        for (int e = 0; e < 8; ++e) z[e] = w1[e] * (c[e] * x[e]);
        if (tp > 0) { unpack8(*(const v4u*)(r - N_SC + D), c); unpack8(*(const v4u*)(r - N_SC + 2 * D), x);
#pragma unroll
            for (int e = 0; e < 8; ++e) z[e] += w0[e] * (c[e] * x[e]); }
        if (tp < SEQ - 1) { unpack8(*(const v4u*)(r + N_SC + D), c); unpack8(*(const v4u*)(r + N_SC + 2 * D), x);
#pragma unroll
            for (int e = 0; e < 8; ++e) z[e] += w2[e] * (c[e] * x[e]); }
#pragma unroll
        for (int e = 0; e < 8; ++e) z[e] *= gb[e];
        *(v4u*)(Y + (size_t)m * D + c0) = pack8(z);
    }
}

__device__ __forceinline__ void ffnact_phase(const bf16* UP, const float* wc, bf16* ACT, int gtid, int NT) {
    constexpr int CB = FF / 8;
    for (int idx = gtid; idx < M * CB; idx += NT) {
        const int m = idx / CB, c0 = (idx - m * CB) * 8, tp = m & (SEQ - 1);
        const bf16* r = UP + (size_t)m * N_FI + c0;
        float g[8], v[8], a[8], b[8];
        unpack8(*(const v4u*)(r), a); unpack8(*(const v4u*)(r + FF), b);
#pragma unroll
        for (int e = 0; e < 8; ++e) { g[e] = wc[N_FI + c0 + e] * a[e]; v[e] = wc[N_FI + FF + c0 + e] * b[e]; }
        if (tp > 0) { unpack8(*(const v4u*)(r - N_FI), a); unpack8(*(const v4u*)(r - N_FI + FF), b);
#pragma unroll
            for (int e = 0; e < 8; ++e) { g[e] += wc[c0 + e] * a[e]; v[e] += wc[FF + c0 + e] * b[e]; } }
        if (tp < SEQ - 1) { unpack8(*(const v4u*)(r + N_FI), a); unpack8(*(const v4u*)(r + N_FI + FF), b);
#pragma unroll
            for (int e = 0; e < 8; ++e) { g[e] += wc[2 * N_FI + c0 + e] * a[e]; v[e] += wc[2 * N_FI + FF + c0 + e] * b[e]; } }
#pragma unroll
        for (int e = 0; e < 8; ++e) g[e] = g[e] * fsig(g[e]) * v[e];
        *(v4u*)(ACT + (size_t)m * FF + c0) = pack8(g);
    }
}

struct Args { const float* in[15]; float* out; unsigned char* ws; int ph_lo, ph_hi; };
constexpr int N_PHASES = 1 + 2 * 9 + 2 * 8;

template <class Epi>
__device__ __forceinline__ void run_gemm(LAS unsigned char* lds, const bf16* A, const bf16* Bt, int N, int K, const Epi& E) {
    pg8::Gemm g{A, Bt, M, N, K}; pg8::StaticOrder S; S.init(M, N, (int)gridDim.x, (int)blockIdx.x);
    pg8::gemm_phase<Epi, pg8::StaticOrder, true, true>(lds, g, S, E);
}

__global__ void __launch_bounds__(NTHR, 2) mega_fwd(Args args) {
    extern __shared__ __attribute__((aligned(16))) unsigned char lds_raw[];
    LAS unsigned char* lds = (LAS unsigned char*)lds_raw;
    cg::grid_group grid = cg::this_grid();
    const int lo = args.ph_lo, hi = args.ph_hi;
    int ph = 0;
#define PH_BEGIN if (ph >= lo && ph < hi) { \
    int tid = threadIdx.x; asm volatile("" : "+v"(tid)); \
    const int lane = tid & 63, wave = __builtin_amdgcn_readfirstlane(tid >> 6); \
    const int G = gridDim.x, gw = blockIdx.x * NWAVES + wave, NGW = G * NWAVES, gtid = blockIdx.x * NTHR + tid, NT = G * NTHR; \
    unsigned char* ws = args.ws; asm volatile("" : "+s"(ws)); \
    (void)lane; (void)gw; (void)NGW; (void)gtid; (void)NT;
#define PH_END } ++ph; if (ph - 1 >= lo && ph < hi) grid.sync();
#define x_in args.in[0]
#define hg_w_in args.in[1]
#define hg_w_out args.in[2]
#define hg_gn args.in[3]
#define hg_lb args.in[4]
#define sc_w_in args.in[5]
#define sc_w_conv args.in[6]
#define sc_w_out args.in[7]
#define ff_w_in args.in[8]
#define ff_w_conv args.in[9]
#define ff_w_out args.in[10]
#define n_pre_mix args.in[11]
#define n_post_mix args.in[12]
#define n_pre_ffn args.in[13]
#define n_post_ffn args.in[14]
#define WHGI ((bf16*)(ws + WS_WHGI))
#define WHGO ((bf16*)(ws + WS_WHGO))
#define WSCI ((bf16*)(ws + WS_WSCI))
#define WSCO ((bf16*)(ws + WS_WSCO))
#define WFI ((bf16*)(ws + WS_WFI))
#define WFO ((bf16*)(ws + WS_WFO))
#define X ((float*)(ws + WS_X))
#define XN ((bf16*)(ws + WS_XN))
#define MB ((float*)(ws + WS_MBUF))
#define U (ws + WS_U)
#define ACT ((bf16*)(ws + WS_ACT))
#define Y ((bf16*)(ws + WS_ACT))
#define Qb ((bf16*)(ws + WS_U + U_Q))
#define Vb ((bf16*)(ws + WS_U + U_V))
#define Gb ((bf16*)(ws + WS_U + U_G))
#define LFf ((float*)(ws + WS_U + U_LFF))
#define LFb ((float*)(ws + WS_U + U_LFB))
#define Of ((float*)(ws + WS_REC))
#define Ob ((float*)(ws + WS_REC + 64 * MiB))

    PH_BEGIN
        LAS float* scr = (LAS float*)(lds + wave * 16384);
        for (int j = 0; j < 2; ++j) {
            transpose_matrix(hg_w_in + (size_t)j * D * N_HG, D, N_HG, WHGI + (size_t)j * N_HG * D, scr, gw, NGW, lane);
            transpose_matrix(hg_w_out + (size_t)j * D * D, D, D, WHGO + (size_t)j * D * D, scr, gw, NGW, lane);
            transpose_matrix(sc_w_in + (size_t)j * D * N_SC, D, N_SC, WSCI + (size_t)j * N_SC * D, scr, gw, NGW, lane);
            transpose_matrix(sc_w_out + (size_t)j * D * D, D, D, WSCO + (size_t)j * D * D, scr, gw, NGW, lane);
        }
        for (int i = 0; i < DEPTH; ++i) {
            transpose_matrix(ff_w_in + (size_t)i * D * N_FI, D, N_FI, WFI + (size_t)i * N_FI * D, scr, gw, NGW, lane);
            transpose_matrix(ff_w_out + (size_t)i * FF * D, FF, D, WFO + (size_t)i * D * FF, scr, gw, NGW, lane);
        }
        rownorm_phase(x_in, nullptr, nullptr, n_pre_mix, X, XN, gw, NGW, lane);
    PH_END

    for (int i = 0; i < DEPTH; ++i) {
        const int j = i >> 1;
        if ((i & 1) == 0) {
            PH_BEGIN
                pg8::EpiHgrn E{U, hg_lb, j};
                run_gemm(lds, XN, WHGI + (size_t)j * N_HG * D, N_HG, D, E);
            PH_END
            PH_BEGIN
                rec_naive_phase(Qb, Vb, LFf, LFb, Of, Ob, gw, NGW, lane);
            PH_END
            PH_BEGIN
                gate_phase(Of, Ob, Gb, hg_gn + (size_t)j * HK, Y, gw, NGW, lane);
            PH_END
            PH_BEGIN
                pg8::EpiF32 E{MB, D};
                run_gemm(lds, Y, WHGO + (size_t)j * D * D, D, D, E);
            PH_END
        } else {
            PH_BEGIN
                pg8::EpiBf16 E{(bf16*)U, N_SC};
                run_gemm(lds, XN, WSCI + (size_t)j * N_SC * D, N_SC, D, E);
            PH_END
            PH_BEGIN
                sconv_phase((const bf16*)U, sc_w_conv + (size_t)j * 3 * D, Y, gtid, NT);
            PH_END
            PH_BEGIN
                pg8::EpiF32 E{MB, D};
                run_gemm(lds, Y, WSCO + (size_t)j * D * D, D, D, E);
            PH_END
        }
        PH_BEGIN
            rownorm_phase(X, MB, n_post_mix + (size_t)i * D, n_pre_ffn + (size_t)i * D, X, XN, gw, NGW, lane);
        PH_END
        PH_BEGIN
            pg8::EpiBf16 E{(bf16*)U, N_FI};
            run_gemm(lds, XN, WFI + (size_t)i * N_FI * D, N_FI, D, E);
        PH_END
        PH_BEGIN
            ffnact_phase((const bf16*)U, ff_w_conv + (size_t)i * 3 * N_FI, ACT, gtid, NT);
        PH_END
        PH_BEGIN
            pg8::EpiF32 E{MB, D};
            run_gemm(lds, ACT, WFO + (size_t)i * D * FF, D, FF, E);
        PH_END
        PH_BEGIN
            if (i == DEPTH - 1) rownorm_phase(X, MB, n_post_ffn + (size_t)i * D, nullptr, args.out, nullptr, gw, NGW, lane);
            else rownorm_phase(X, MB, n_post_ffn + (size_t)i * D, n_pre_mix + (size_t)(i + 1) * D, X, XN, gw, NGW, lane);
        PH_END
    }
#undef PH_BEGIN
#undef PH_END
#undef X
#undef Y
#undef U
}

#ifndef MK_MULTI
#define MK_MULTI 0
#endif
extern "C" void kernel_launch(void* const* d_in, const int* in_sizes, int n_in, void* d_out, int out_size, void* d_ws, size_t ws_size, hipStream_t stream) {
    static int grid = 0;
    if (grid == 0) {
        if (n_in != 15 || out_size != M * D || ws_size < WS_END) { fprintf(stderr, "kernel_launch: unexpected shapes (n_in %d out %d ws %zu)\n", n_in, out_size, ws_size); grid = -1; return; }
        int dev = 0, cus = 0, per_cu = 0;
        hipGetDevice(&dev); hipDeviceGetAttribute(&cus, hipDeviceAttributeMultiprocessorCount, dev);
        if (hipFuncSetAttribute((const void*)mega_fwd, hipFuncAttributeMaxDynamicSharedMemorySize, LDS_BYTES) != hipSuccess) { fprintf(stderr, "hipFuncSetAttribute failed\n"); grid = -1; return; }
        if (hipOccupancyMaxActiveBlocksPerMultiprocessor(&per_cu, (const void*)mega_fwd, NTHR, LDS_BYTES) != hipSuccess || per_cu < 1) { fprintf(stderr, "occupancy query: %d\n", per_cu); per_cu = 1; }
        (void)hipGetLastError();
        grid = cus * 1;
    }
    if (grid < 0) return;
    Args a{};
    for (int i = 0; i < 15; ++i) a.in[i] = (const float*)d_in[i];
    a.out = (float*)d_out; a.ws = (unsigned char*)d_ws;
#if MK_MULTI
    for (int p = 0; p < N_PHASES; ++p) { a.ph_lo = p; a.ph_hi = p + 1; hipLaunchKernelGGL(mega_fwd, dim3(grid), dim3(NTHR), LDS_BYTES, stream, a); }
#else
    a.ph_lo = 0; a.ph_hi = N_PHASES;
    void* kargs[] = {&a};
    hipError_t e = hipLaunchCooperativeKernel((const void*)mega_fwd, dim3(grid), dim3(NTHR), kargs, LDS_BYTES, stream);
    if (e != hipSuccess) fprintf(stderr, "cooperative launch failed: %s (grid %d)\n", hipGetErrorString(e), grid);
#endif
}
```

```cpp
#include <hip/hip_runtime.h>
#include <hip/hip_cooperative_groups.h>
#include <cstdio>
#include <cstdint>
namespace cg = cooperative_groups;
namespace pg8 {
#define PG8_LAS __attribute__((address_space(3)))
typedef unsigned short bf16_t;
typedef short bf16x8 __attribute__((ext_vector_type(8)));
typedef float f32x4 __attribute__((ext_vector_type(4)));
typedef unsigned u32x4 __attribute__((ext_vector_type(4)));
constexpr int BM = 256, BK = 64, HALF = 128, HTB = HALF * BK * 2  , STAGE_BYTES = 8 * HTB, NXCD = 8, WGM = 8;

__host__ __device__ __forceinline__ int lds_byte(int r, int c) { const int st = (r >> 4) * 2 + (c >> 5), rr = r & 15, cc = c & 31, ob = rr * 64 + cc * 2; return st * 1024 + (ob ^ (((ob >> 9) & 1) << 5)); }
__host__ __device__ __forceinline__ void stage_rc(int b, int& R, int& C) { const int st = b / 1024, sb = b % 1024, swz = sb ^ (((sb >> 9) & 1) << 5); R = (st >> 1) * 16 + swz / 64; C = (st & 1) * 32 + (swz % 64) / 2; }
__host__ __device__ __forceinline__ int perm32(int rho) { const int n = rho >> 4, i = rho & 15; return 8 * (i >> 2) + 4 * n + (i & 3); }

struct Unit { int pm, pn; };
struct Gemm { const bf16_t* A; const bf16_t* Bt; int M, N, K; };

struct StaticOrder {
    int nM, nN, nwg, G, c;
    __host__ __device__ void init(int M, int N, int G_, int c_) { nM = M / BM; nN = N / BM; nwg = nM * nN; G = G_; c = c_; }
    __host__ __device__ bool next(int i, Unit& u) const {
        const long L = (long)i * G + c; if (L >= nwg) return false;
        int wgid = (int)L; { const int q = nwg / NXCD, r = nwg % NXCD, xcd = wgid % NXCD, off = wgid / NXCD; wgid = (xcd < r ? xcd * (q + 1) : r * (q + 1) + (xcd - r) * q) + off; }
        const int nig = WGM * nN, gid = wgid / nig, fm = gid * WGM, gsz = (nM - fm) < WGM ? (nM - fm) : WGM;
        u.pm = fm + ((wgid % nig) % gsz); u.pn = (wgid % nig) / gsz; return true;
    }
    __device__ __forceinline__ void a_ready(const Unit&) const {}
    __device__ __forceinline__ void done(const Unit&) const {}
};
__device__ __forceinline__ unsigned cvt_pk_bf16(float lo, float hi) { unsigned r; asm volatile("v_cvt_pk_bf16_f32 %0, %1, %2" : "=v"(r) : "v"(lo), "v"(hi)); return r; }
typedef float f32x2 __attribute__((ext_vector_type(2)));
template <class Epi, class Sched, bool ALIGN_EPI = false, bool SP2 = false>
__device__ __forceinline__ void gemm_phase(PG8_LAS unsigned char* lds, const Gemm g, const Sched& S, const Epi& E) {
    int tid_o = threadIdx.x; asm volatile("" : "+v"(tid_o));
    const int tid = tid_o, wid = __builtin_amdgcn_readfirstlane(tid >> 6), lane = tid & 63, wr = wid >> 2, wc = wid & 3, fr = lane & 15, fq = lane >> 4;
    const int K = g.K, nt = K / BK;
    unsigned voffA[2], voffB[2];
#pragma unroll
    for (int i = 0; i < 2; ++i) { int R, C; stage_rc(tid * 16 + i * 8192, R, C); const int Rb = Epi::PERM ? ((R & ~31) + perm32(R & 31)) : R;
        voffA[i] = (unsigned)(R * K + C) * 2u; voffB[i] = (unsigned)(Rb * K + C) * 2u; }
    const size_t kstep = (size_t)(BK * 2);
    const size_t hstep = (size_t)HALF * K * 2;
    const size_t tstep = 2 * hstep;
    const unsigned ldsw = (unsigned)wid * 1024u;
    const int aoff = lds_byte(wr * 64 + fr, fq * 8), boff = lds_byte(wc * 32 + fr, fq * 8);
#define PG8_SA(b, h) (((b) * 2 + (h)) * HTB)
#define PG8_SB(b, h) ((4 + (b) * 2 + (h)) * HTB)
#define PG8_STAGE(bufoff, gbase, voff) do { _Pragma("unroll") for (int _i = 0; _i < 2; ++_i) \
        __builtin_amdgcn_global_load_lds((const unsigned*)((const char*)(gbase) + (voff)[_i]), (PG8_LAS unsigned*)(lds + (bufoff) + ldsw + _i * 8192), 16, 0, 0); } while (0)
#define PG8_LDA(dst, b, h) do { _Pragma("unroll") for (int m = 0; m < 4; ++m) _Pragma("unroll") for (int k = 0; k < 2; ++k) dst[m][k] = *(const PG8_LAS bf16x8*)(lds + PG8_SA(b, h) + aoff + m * 2048 + k * 1024); } while (0)
#define PG8_LDB(dst, b, h) do { _Pragma("unroll") for (int n = 0; n < 2; ++n) _Pragma("unroll") for (int k = 0; k < 2; ++k) dst[n][k] = *(const PG8_LAS bf16x8*)(lds + PG8_SB(b, h) + boff + n * 2048 + k * 1024); } while (0)
#define PG8_MMA(ai, bj, At, Bt) do { __builtin_amdgcn_s_setprio(1); _Pragma("unroll") for (int m = 0; m < 4; ++m) _Pragma("unroll") for (int n = 0; n < 2; ++n) _Pragma("unroll") for (int k = 0; k < 2; ++k) \
        acc[ai][bj][m][n] = __builtin_amdgcn_mfma_f32_16x16x32_bf16(Bt[n][k], At[m][k], acc[ai][bj][m][n], 0, 0, 0); __builtin_amdgcn_s_setprio(0); } while (0)
#define PG8_WAIT_V(n) asm volatile("s_waitcnt vmcnt(" #n ")" ::: "memory")
#define PG8_WAIT_L(n) asm volatile("s_waitcnt lgkmcnt(" #n ")" ::: "memory")
#define PG8_BAR __builtin_amdgcn_s_barrier()
#define PG8_SCHED __builtin_amdgcn_sched_barrier(0)
    Unit cur, nxt; int ui = 0;
    if (!S.next(0, cur)) return;
    f32x4 acc[2][2][4][2];
#pragma unroll
    for (int a = 0; a < 2; ++a)
#pragma unroll
        for (int b = 0; b < 2; ++b)
#pragma unroll
            for (int m = 0; m < 4; ++m)
#pragma unroll
                for (int n = 0; n < 2; ++n) acc[a][b][m][n] = (f32x4){0.f, 0.f, 0.f, 0.f};
    bf16x8 At[4][2], B0[2][2], B1[2][2];
    const char* cA = (const char*)g.A + (size_t)cur.pm * tstep; const char* cB = (const char*)g.Bt + (size_t)cur.pn * tstep;
    S.a_ready(cur);
    if constexpr (SP2) {
        PG8_STAGE(PG8_SB(0, 0), cB, voffB); PG8_STAGE(PG8_SB(0, 1), cB + hstep, voffB); PG8_STAGE(PG8_SA(0, 0), cA, voffA); PG8_STAGE(PG8_SA(0, 1), cA + hstep, voffA);
        if (wr == 1) PG8_BAR;
        PG8_WAIT_V(2); PG8_BAR;
        PG8_STAGE(PG8_SB(1, 0), cB + kstep, voffB); PG8_STAGE(PG8_SA(1, 0), cA + kstep, voffA); PG8_STAGE(PG8_SB(1, 1), cB + hstep + kstep, voffB);
        PG8_WAIT_V(6); PG8_BAR;
    } else {
        PG8_STAGE(PG8_SB(0, 0), cB, voffB); PG8_STAGE(PG8_SA(0, 0), cA, voffA); PG8_STAGE(PG8_SB(0, 1), cB + hstep, voffB); PG8_STAGE(PG8_SA(0, 1), cA + hstep, voffA);
        if (wr == 1) PG8_BAR;
        PG8_WAIT_V(4); PG8_BAR;
        PG8_STAGE(PG8_SB(1, 0), cB + kstep, voffB); PG8_STAGE(PG8_SA(1, 0), cA + kstep, voffA); PG8_STAGE(PG8_SB(1, 1), cB + hstep + kstep, voffB);
        PG8_WAIT_V(6); PG8_BAR;
    }
    for (;;) {
        const bool has_next = S.next(ui + 1, nxt);
        const char* nA = has_next ? (const char*)g.A + (size_t)nxt.pm * tstep : cA; const char* nB = has_next ? (const char*)g.Bt + (size_t)nxt.pn * tstep : cB;
        for (int t = 0; t < nt; t += 2) {
            const bool last = (t == nt - 2);
            const char* a1 = cA + (size_t)(t + 1) * kstep;
            const char* a2 = last ? nA : cA + (size_t)(t + 2) * kstep; const char* b2 = last ? nB : cB + (size_t)(t + 2) * kstep;
            const char* a3 = a2 + kstep; const char* b3 = b2 + kstep;
            if (last && has_next) S.a_ready(nxt);
            if constexpr (SP2) {
            PG8_LDB(B0, 0, 0); PG8_LDB(B1, 0, 1); PG8_SCHED; PG8_LDA(At, 0, 0); PG8_STAGE(PG8_SA(1, 1), a1 + hstep, voffA);
            PG8_WAIT_V(8); PG8_WAIT_L(0); PG8_BAR; PG8_MMA(0, 0, At, B0); PG8_MMA(0, 1, At, B1); PG8_BAR; PG8_SCHED;
            PG8_LDA(At, 0, 1); PG8_STAGE(PG8_SB(0, 0), b2, voffB); PG8_STAGE(PG8_SB(0, 1), b2 + hstep, voffB); PG8_STAGE(PG8_SA(0, 0), a2, voffA);
            PG8_WAIT_V(8); PG8_WAIT_L(0); PG8_BAR; PG8_MMA(1, 0, At, B0); PG8_MMA(1, 1, At, B1); PG8_BAR; PG8_SCHED;
            PG8_LDB(B0, 1, 0); PG8_LDB(B1, 1, 1); PG8_SCHED; PG8_LDA(At, 1, 0); PG8_STAGE(PG8_SA(0, 1), a2 + hstep, voffA);
            PG8_WAIT_V(8); PG8_WAIT_L(0); PG8_BAR; PG8_MMA(0, 0, At, B0); PG8_MMA(0, 1, At, B1); PG8_BAR; PG8_SCHED;
            PG8_LDA(At, 1, 1); PG8_STAGE(PG8_SB(1, 0), b3, voffB); PG8_STAGE(PG8_SB(1, 1), b3 + hstep, voffB); PG8_STAGE(PG8_SA(1, 0), a3, voffA);
            PG8_WAIT_V(8); PG8_WAIT_L(0); PG8_BAR; PG8_MMA(1, 0, At, B0); PG8_MMA(1, 1, At, B1); PG8_BAR; PG8_SCHED;
            } else {
            PG8_LDB(B0, 0, 0); PG8_SCHED; PG8_LDA(At, 0, 0); PG8_STAGE(PG8_SA(1, 1), a1 + hstep, voffA);
            PG8_WAIT_L(8); PG8_BAR; PG8_WAIT_L(0); PG8_MMA(0, 0, At, B0); PG8_BAR; PG8_SCHED;
            PG8_LDB(B1, 0, 1); PG8_STAGE(PG8_SB(0, 0), b2, voffB);
            PG8_BAR; PG8_WAIT_L(0); PG8_MMA(0, 1, At, B1); PG8_BAR;
            PG8_LDA(At, 0, 1); PG8_STAGE(PG8_SA(0, 0), a2, voffA);
            PG8_BAR; PG8_WAIT_L(0); PG8_MMA(1, 0, At, B0); PG8_BAR; PG8_SCHED;
            PG8_STAGE(PG8_SB(0, 1), b2 + hstep, voffB);
            PG8_WAIT_V(6); PG8_BAR; PG8_MMA(1, 1, At, B1); PG8_BAR;
            PG8_LDB(B0, 1, 0); PG8_SCHED; PG8_LDA(At, 1, 0); PG8_STAGE(PG8_SA(0, 1), a2 + hstep, voffA);
            PG8_WAIT_L(8); PG8_BAR; PG8_WAIT_L(0); PG8_MMA(0, 0, At, B0); PG8_BAR; PG8_SCHED;
            PG8_LDB(B1, 1, 1); PG8_STAGE(PG8_SB(1, 0), b3, voffB);
            PG8_BAR; PG8_WAIT_L(0); PG8_MMA(0, 1, At, B1); PG8_BAR;
            PG8_LDA(At, 1, 1); PG8_STAGE(PG8_SA(1, 0), a3, voffA);
            PG8_BAR; PG8_WAIT_L(0); PG8_MMA(1, 0, At, B0); PG8_BAR; PG8_SCHED;
            PG8_STAGE(PG8_SB(1, 1), b3 + hstep, voffB);
            PG8_WAIT_V(6); PG8_BAR; PG8_MMA(1, 1, At, B1); PG8_BAR;
            }
        }
        if constexpr (ALIGN_EPI) { if (wr == 0) PG8_BAR; }
        if constexpr (!Epi::AFTER_DRAIN) { E(acc, cur, wr, wc, fr, fq); S.done(cur); }
        if (!has_next) break;
#pragma unroll
        for (int a = 0; a < 2; ++a)
#pragma unroll
            for (int b = 0; b < 2; ++b)
#pragma unroll
                for (int m = 0; m < 4; ++m)
#pragma unroll
                    for (int n = 0; n < 2; ++n) acc[a][b][m][n] = (f32x4){0.f, 0.f, 0.f, 0.f};
        cur = nxt; cA = nA; cB = nB; ++ui;
        if constexpr (ALIGN_EPI) { if (wr == 1) PG8_BAR; }
    }
    PG8_WAIT_V(0);
    if constexpr (!ALIGN_EPI) { if (wr == 0) PG8_BAR; }
    PG8_BAR;
    if constexpr (Epi::AFTER_DRAIN) { E.fused(acc, cur, wr, wc, fr, fq, lds, wid, lane); S.done(cur); }
#undef PG8_SA
#undef PG8_SB
#undef PG8_STAGE
#undef PG8_LDA
#undef PG8_LDB
#undef PG8_MMA
#undef PG8_WAIT_V
#undef PG8_WAIT_L
#undef PG8_BAR
#undef PG8_SCHED
}
}
namespace pg8 {
__device__ __forceinline__ float fsigmoid(float x) { return __builtin_amdgcn_rcpf(1.0f + __expf(-x)); }
struct EpiF32 {
    static constexpr bool PERM = false, AFTER_DRAIN = false;
    float* C; int ldc;
    __device__ __forceinline__ void operator()(const f32x4 (&acc)[2][2][4][2], const Unit& u, int wr, int wc, int fr, int fq) const {
        const int row0 = u.pm * BM + wr * 64 + fr, col0 = u.pn * BM + wc * 32 + 4 * fq;
#pragma unroll
        for (int ai = 0; ai < 2; ++ai)
#pragma unroll
            for (int m = 0; m < 4; ++m) { float* rowp = C + (size_t)(row0 + ai * HALF + m * 16) * ldc + col0;
#pragma unroll
                for (int bj = 0; bj < 2; ++bj)
#pragma unroll
                    for (int n = 0; n < 2; ++n) *(f32x4*)(rowp + bj * HALF + n * 16) = acc[ai][bj][m][n]; }
    }
};
struct EpiBf16 {
    static constexpr bool PERM = true, AFTER_DRAIN = false;
    bf16_t* O; int ldc;
    __device__ __forceinline__ void operator()(const f32x4 (&acc)[2][2][4][2], const Unit& u, int wr, int wc, int fr, int fq) const {
        const int row0 = u.pm * BM + wr * 64 + fr, col0 = u.pn * BM + wc * 32 + 8 * fq;
#pragma unroll
        for (int ai = 0; ai < 2; ++ai)
#pragma unroll
            for (int m = 0; m < 4; ++m) { bf16_t* rowp = O + (size_t)(row0 + ai * HALF + m * 16) * ldc + col0;
#pragma unroll
                for (int bj = 0; bj < 2; ++bj) { const f32x4 v0 = acc[ai][bj][m][0], v1 = acc[ai][bj][m][1];
                    u32x4 w; w.x = cvt_pk_bf16(v0[0], v0[1]); w.y = cvt_pk_bf16(v0[2], v0[3]); w.z = cvt_pk_bf16(v1[0], v1[1]); w.w = cvt_pk_bf16(v1[2], v1[3]);
                    *(u32x4*)(rowp + bj * HALF) = w; } }
    }
};
struct EpiHgrn {
    static constexpr bool PERM = true, AFTER_DRAIN = false;
    unsigned char* Ub; const float* lbs; int layer_j;
    __device__ __forceinline__ void operator()(const f32x4 (&acc)[2][2][4][2], const Unit& u, int wr, int wc, int fr, int fq) const {
        const int seg = u.pn >> 3, colt = (u.pn & 7) * BM;
        const int row0 = u.pm * BM + wr * 64 + fr, col0 = colt + wc * 32 + 8 * fq;
        if (seg == 1 || seg == 2) {
            const int dir = seg - 1; float* LF = (float*)(Ub + ((size_t)(96 + 64 * dir) << 20));
#pragma unroll
            for (int bj = 0; bj < 2; ++bj) {
                float lb[8];
#pragma unroll
                for (int e = 0; e < 8; ++e) lb[e] = 0.f;
                if (layer_j == 1) {
                    const f32x4 a0 = *(const f32x4*)(lbs + (size_t)(dir * 2 + 0) * 2048 + col0 + bj * HALF), a1 = *(const f32x4*)(lbs + (size_t)(dir * 2 + 0) * 2048 + col0 + bj * HALF + 4);
                    const f32x4 b0 = *(const f32x4*)(lbs + (size_t)(dir * 2 + 1) * 2048 + col0 + bj * HALF), b1 = *(const f32x4*)(lbs + (size_t)(dir * 2 + 1) * 2048 + col0 + bj * HALF + 4);
#pragma unroll
                    for (int e = 0; e < 4; ++e) { lb[e] = fsigmoid(b0[e] - a0[e]); lb[4 + e] = fsigmoid(b1[e] - a1[e]); }
                }
#pragma unroll
                for (int ai = 0; ai < 2; ++ai)
#pragma unroll
                    for (int m = 0; m < 4; ++m) { float* rowp = LF + (size_t)(row0 + ai * HALF + m * 16) * 2048 + col0 + bj * HALF;
#pragma unroll
                        for (int n = 0; n < 2; ++n) { f32x4 o;
#pragma unroll
                            for (int e = 0; e < 4; ++e) { const float s = fsigmoid(acc[ai][bj][m][n][e]); const float l = lb[4 * n + e]; o[e] = __logf(l + (1.0f - l) * s); }
                            *(f32x4*)(rowp + 4 * n) = o; } }
            }
        } else {
            const int sel = (seg == 0) ? 0 : ((seg == 3) ? 1 : 2); bf16_t* O = (bf16_t*)(Ub + ((size_t)(32 * sel) << 20)); const bool act = (seg != 3);
#pragma unroll
            for (int ai = 0; ai < 2; ++ai)
#pragma unroll
                for (int m = 0; m < 4; ++m) { bf16_t* rowp = O + (size_t)(row0 + ai * HALF + m * 16) * 2048 + col0;
#pragma unroll
                    for (int bj = 0; bj < 2; ++bj) { f32x4 v0 = acc[ai][bj][m][0], v1 = acc[ai][bj][m][1];
                        if (act) {
#pragma unroll
                            for (int e = 0; e < 4; ++e) { v0[e] = v0[e] * fsigmoid(v0[e]); v1[e] = v1[e] * fsigmoid(v1[e]); } }
                        u32x4 w; w.x = cvt_pk_bf16(v0[0], v0[1]); w.y = cvt_pk_bf16(v0[2], v0[3]); w.z = cvt_pk_bf16(v1[0], v1[1]); w.w = cvt_pk_bf16(v1[2], v1[3]);
                        *(u32x4*)(rowp + bj * HALF) = w; } }
        }
    }
};
}
#define GAS __attribute__((address_space(1)))
#define LAS __attribute__((address_space(3)))
typedef unsigned short bf16;
typedef unsigned v4u __attribute__((ext_vector_type(4)));
typedef unsigned v2u __attribute__((ext_vector_type(2)));
typedef float f32x4 __attribute__((ext_vector_type(4)));
typedef short bf16x8 __attribute__((ext_vector_type(8)));
constexpr int NWAVES = 8, NTHR = 512;
constexpr int D = 2048, BATCH = 2, SEQ = 4096, M = BATCH * SEQ, DEPTH = 4, NH = 16, HK = 128, FF = 5632;
constexpr int N_HG = 5 * D, N_SC = 3 * D, N_FI = 2 * FF;
constexpr float EPS = 1e-6f;
constexpr size_t MiB = 1u << 20;
constexpr size_t WS_CTL = 0, WS_WHGI = 2 * MiB, WS_WHGO = 82 * MiB, WS_WSCI = 98 * MiB, WS_WSCO = 146 * MiB, WS_WFI = 162 * MiB, WS_WFO = 338 * MiB;
constexpr size_t WS_X = 426 * MiB, WS_XN = 490 * MiB, WS_MBUF = 522 * MiB, WS_U = 586 * MiB, WS_ACT = 810 * MiB, WS_REC = 898 * MiB, WS_END = 1286 * MiB;
constexpr size_t U_Q = 0, U_V = 32 * MiB, U_G = 64 * MiB, U_LFF = 96 * MiB, U_LFB = 160 * MiB;
constexpr int LDS_BYTES = 147456;

__device__ __forceinline__ unsigned f2bf(float f) { unsigned u = __builtin_bit_cast(unsigned, f); return (u + 0x7fffu + ((u >> 16) & 1u)) >> 16; }
__device__ __forceinline__ unsigned pk2(float lo, float hi) { return f2bf(lo) | (f2bf(hi) << 16); }
__device__ __forceinline__ float bflo(unsigned w) { return __builtin_bit_cast(float, w << 16); }
__device__ __forceinline__ float bfhi(unsigned w) { return __builtin_bit_cast(float, w & 0xffff0000u); }
__device__ __forceinline__ float bf2f(bf16 b) { return __builtin_bit_cast(float, ((unsigned)b) << 16); }
__device__ __forceinline__ float wave_sum(float v) {
#pragma unroll
    for (int o = 1; o < 64; o <<= 1) v += __shfl_xor(v, o);
    return v;
}
__device__ __forceinline__ float fsig(float x) { return __builtin_amdgcn_rcpf(1.0f + __expf(-x)); }
#define LDS_WAIT() asm volatile("s_waitcnt lgkmcnt(0)" ::: "memory")

__device__ __forceinline__ void p0_transpose_item(const float* W, int K, int N, bf16* WT, LAS float* scr, int item, int lane) {
    const int nblk = N / 32, kb = item / nblk, nb = item % nblk, k0 = 64 * kb, n0 = 32 * nb;
#pragma unroll 8
    for (int i = 0; i < 32; ++i) { const int kk = 2 * i + (lane >> 5); scr[kk * 33 + (lane & 31)] = W[(size_t)(k0 + kk) * N + n0 + (lane & 31)]; }
    LDS_WAIT(); asm volatile("" ::: "memory");
    const int c = lane & 7;
#pragma unroll
    for (int j = 0; j < 4; ++j) { const int n = (lane >> 3) + 8 * j; const LAS float* s = scr + (8 * c) * 33 + n;
        v4u o; o.x = pk2(s[0 * 33], s[1 * 33]); o.y = pk2(s[2 * 33], s[3 * 33]); o.z = pk2(s[4 * 33], s[5 * 33]); o.w = pk2(s[6 * 33], s[7 * 33]);
        *(v4u*)(WT + (size_t)(n0 + n) * K + k0 + 8 * c) = o; }
    LDS_WAIT(); asm volatile("" ::: "memory");
}
__device__ __forceinline__ void transpose_matrix(const float* W, int K, int N, bf16* WT, LAS float* scr, int gw, int NGW, int lane) {
    const int items = (K / 64) * (N / 32);
    for (int it = gw; it < items; it += NGW) p0_transpose_item(W, K, N, WT, scr, it, lane);
}

__device__ __forceinline__ void rownorm_phase(const float* xin, const float* mb, const float* w_post, const float* w_next, float* xout, bf16* xn, int gw, int NGW, int lane) {
    for (int m = gw; m < M; m += NGW) {
        const f32x4* xr = (const f32x4*)(xin + (size_t)m * D) + lane;
        f32x4 x[8];
#pragma unroll
        for (int j = 0; j < 8; ++j) x[j] = xr[64 * j];
        if (mb) {
            const f32x4* mr = (const f32x4*)(mb + (size_t)m * D) + lane;
            f32x4 mm[8]; float ss = 0.f;
#pragma unroll
            for (int j = 0; j < 8; ++j) { mm[j] = mr[64 * j]; ss += (mm[j].x * mm[j].x + mm[j].y * mm[j].y) + (mm[j].z * mm[j].z + mm[j].w * mm[j].w); }
            const float rstd = __builtin_amdgcn_rsqf(wave_sum(ss) * (1.f / D) + EPS);
#pragma unroll
            for (int j = 0; j < 8; ++j) { const f32x4 w = ((const f32x4*)w_post)[lane + 64 * j]; x[j] = x[j] + mm[j] * rstd * w; }
        }
        if (xout) { f32x4* o = (f32x4*)(xout + (size_t)m * D) + lane;
#pragma unroll
            for (int j = 0; j < 8; ++j) o[64 * j] = x[j]; }
        if (xn) {
            float s2 = 0.f;
#pragma unroll
            for (int j = 0; j < 8; ++j) s2 += (x[j].x * x[j].x + x[j].y * x[j].y) + (x[j].z * x[j].z + x[j].w * x[j].w);
            const float r2 = __builtin_amdgcn_rsqf(wave_sum(s2) * (1.f / D) + EPS);
            v2u* o8 = (v2u*)(xn + (size_t)m * D) + lane;
#pragma unroll
            for (int j = 0; j < 8; ++j) { const f32x4 w = ((const f32x4*)w_next)[lane + 64 * j]; v2u o; o.x = pk2(x[j].x * r2 * w.x, x[j].y * r2 * w.y); o.y = pk2(x[j].z * r2 * w.z, x[j].w * r2 * w.w); o8[64 * j] = o; }
        }
    }
}

__device__ __forceinline__ void unpack8(const v4u a, float (&f)[8]) { f[0] = bflo(a.x); f[1] = bfhi(a.x); f[2] = bflo(a.y); f[3] = bfhi(a.y); f[4] = bflo(a.z); f[5] = bfhi(a.z); f[6] = bflo(a.w); f[7] = bfhi(a.w); }
__device__ __forceinline__ v4u pack8(const float (&f)[8]) { v4u o; o.x = pk2(f[0], f[1]); o.y = pk2(f[2], f[3]); o.z = pk2(f[4], f[5]); o.w = pk2(f[6], f[7]); return o; }

typedef pg8::bf16x8 bfx8;
#define MFMA16(a, b, c) __builtin_amdgcn_mfma_f32_16x16x32_bf16(a, b, c, 0, 0, 0)
constexpr int QS = 136, TS = 72;
constexpr int OSS = 132;
constexpr int L_QD = 0, L_QH = 64 * QS * 2, L_KH = 2 * 64 * QS * 2, L_VT = 3 * 64 * QS * 2, L_AM = L_VT + 128 * TS * 2, L_OS = L_AM + 64 * TS * 2, L_TOT = L_OS + 64 * OSS * 4, L_RECEND = L_TOT + 2048;
static_assert(L_RECEND <= 131072, "LDS map of the recurrence passes");
constexpr size_t REC_UT = 0, REC_ST = 256 * MiB, REC_DEC = 384 * MiB;

__device__ __forceinline__ void chunk_cumsum(const float* LFbase, int t0, int dir, int k, int ig, LAS float* TOT, float (&lf)[16], float (&bb)[16], float& blast, float& r31) {
#pragma unroll
    for (int j = 0; j < 16; ++j) { const int i = 16 * ig + j; const int t = dir ? (t0 + 63 - i) : (t0 + i); lf[j] = LFbase[(size_t)t * D + k]; }
    float run = 0.f;
#pragma unroll
    for (int j = 0; j < 16; ++j) { run += lf[j]; bb[j] = run; }
    TOT[ig * 128 + k] = run;
    __syncthreads();
    const float s0 = TOT[k], s1 = TOT[128 + k], s2 = TOT[256 + k], s3 = TOT[384 + k];
    const float base = (ig > 0 ? s0 : 0.f) + (ig > 1 ? s1 : 0.f) + (ig > 2 ? s2 : 0.f);
#pragma unroll
    for (int j = 0; j < 16; ++j) bb[j] += base;
    blast = (s0 + s1) + (s2 + s3); r31 = s0 + s1;
}
__device__ __forceinline__ void load_colT(const bf16* base, int t0, int dir, int col, int ig, LAS bf16* T) {
    unsigned w[8];
#pragma unroll
    for (int j = 0; j < 8; ++j) { const int i = 16 * ig + 2 * j; const int ta = dir ? (t0 + 63 - i) : (t0 + i), tb = dir ? (ta - 1) : (ta + 1);
        w[j] = (unsigned)base[(size_t)ta * D + col] | ((unsigned)base[(size_t)tb * D + col] << 16); }
    LAS v4u* o = (LAS v4u*)(T + col * TS + 16 * ig);
    v4u o0, o1; o0.x = w[0]; o0.y = w[1]; o0.z = w[2]; o0.w = w[3]; o1.x = w[4]; o1.y = w[5]; o1.z = w[6]; o1.w = w[7];
    o[0] = o0; o[1] = o1;
}

__device__ __forceinline__ void rec_pass1(LAS unsigned char* lds, const bf16* V, const float* LFf, const float* LFb, float* UT, float* DEC, int tid) {
    const int lane = tid & 63, wave = __builtin_amdgcn_readfirstlane(tid >> 6), k = tid & 127, ig = tid >> 7, fr = lane & 15, fq = lane >> 4;
    LAS bf16* KT = (LAS bf16*)(lds + L_QD); LAS bf16* VT = (LAS bf16*)(lds + L_VT); LAS float* TOT = (LAS float*)(lds + L_TOT);
    for (int task = blockIdx.x; task < 4096; task += gridDim.x) {
        const int c = task & 63, seq = task >> 6, h = seq & 15, b = (seq >> 4) & 1, dir = seq >> 5;
        const int t0 = 64 * (dir ? 63 - c : c);
        const float* LFbase = (dir ? LFb : LFf) + (size_t)b * SEQ * D + h * HK;
        float lf[16], bb[16], blast, r31;
        chunk_cumsum(LFbase, t0, dir, k, ig, TOT, lf, bb, blast, r31);
        unsigned w[8];
#pragma unroll
        for (int j = 0; j < 8; ++j) { const float k0 = (1.0f - __expf(lf[2 * j])) * __expf(blast - bb[2 * j]), k1 = (1.0f - __expf(lf[2 * j + 1])) * __expf(blast - bb[2 * j + 1]); w[j] = pk2(k0, k1); }
        { LAS v4u* o = (LAS v4u*)(KT + k * TS + 16 * ig); v4u o0, o1; o0.x = w[0]; o0.y = w[1]; o0.z = w[2]; o0.w = w[3]; o1.x = w[4]; o1.y = w[5]; o1.z = w[6]; o1.w = w[7]; o[0] = o0; o[1] = o1; }
        load_colT(V + (size_t)b * SEQ * D + h * HK, t0, dir, k, ig, VT);
        if (ig == 0) DEC[(size_t)task * 128 + k] = __expf(blast);
        __syncthreads();
        f32x4 acc[8];
#pragma unroll
        for (int n = 0; n < 8; ++n) acc[n] = (f32x4){0.f, 0.f, 0.f, 0.f};
#pragma unroll
        for (int ks = 0; ks < 2; ++ks) {
            const bfx8 a = *(const LAS bfx8*)(VT + (16 * wave + fr) * TS + 32 * ks + 8 * fq);
#pragma unroll
            for (int n = 0; n < 8; ++n) { const bfx8 bt = *(const LAS bfx8*)(KT + (16 * n + fr) * TS + 32 * ks + 8 * fq); acc[n] = MFMA16(bt, a, acc[n]); }
        }
        float* o = UT + (size_t)task * 16384 + (16 * wave + fr) * 128 + 4 * fq;
#pragma unroll
        for (int n = 0; n < 8; ++n) *(f32x4*)(o + 16 * n) = acc[n];
        __syncthreads();
    }
}
__device__ __forceinline__ void rec_pass2(const float* UT, const float* DEC, bf16* ST, int gtid, int NT) {
    for (int item = gtid; item < 64 * 4096; item += NT) {
        const int seq = item >> 12, e4 = (item & 4095) * 4, k4 = e4 & 127;
        const float* up = UT + (size_t)seq * 64 * 16384 + e4; const float* dp = DEC + (size_t)seq * 64 * 128 + k4; bf16* sp = ST + (size_t)seq * 64 * 16384 + e4;
        f32x4 s = (f32x4){0.f, 0.f, 0.f, 0.f};
#pragma unroll 8
        for (int c = 0; c < 64; ++c) {
            const f32x4 u = *(const f32x4*)(up + (size_t)c * 16384); const f32x4 d = *(const f32x4*)(dp + c * 128);
            v2u o; o.x = pk2(s.x, s.y); o.y = pk2(s.z, s.w); *(v2u*)(sp + (size_t)c * 16384) = o;
            s = d * s + u;
        }
    }
}
__device__ __forceinline__ void rec_pass3(LAS unsigned char* lds, const bf16* Q, const bf16* V, const bf16* Gt, const float* LFf, const float* LFb, const bf16* ST, const float* gnw, bf16* Yo, int tid) {
    const int lane = tid & 63, wave = __builtin_amdgcn_readfirstlane(tid >> 6), k = tid & 127, ig = tid >> 7, fr = lane & 15, fq = lane >> 4;
    LAS bf16* QDl = (LAS bf16*)(lds + L_QD); LAS bf16* QHl = (LAS bf16*)(lds + L_QH); LAS bf16* KHl = (LAS bf16*)(lds + L_KH); LAS bf16* VT = (LAS bf16*)(lds + L_VT);
    LAS bf16* AM = (LAS bf16*)(lds + L_AM); LAS float* OS = (LAS float*)(lds + L_OS); LAS float* TOT = (LAS float*)(lds + L_TOT);
    for (int task = blockIdx.x; task < 2048; task += gridDim.x) {
        const int C = task & 63, h = (task >> 6) & 15, b = task >> 10, t0 = 64 * C;
#pragma unroll 1
        for (int dir = 0; dir < 2; ++dir) {
            const int c = dir ? 63 - C : C, seq = (dir * 2 + b) * 16 + h;
            const float* LFbase = (dir ? LFb : LFf) + (size_t)b * SEQ * D + h * HK;
            float lf[16], bb[16], blast, r31;
            chunk_cumsum(LFbase, t0, dir, k, ig, TOT, lf, bb, blast, r31);
            const bf16* Qbase = Q + (size_t)b * SEQ * D + h * HK + k;
#pragma unroll
            for (int j = 0; j < 16; ++j) { const int i = 16 * ig + j; const int t = dir ? (t0 + 63 - i) : (t0 + i);
                const float qv = bf2f(Qbase[(size_t)t * D]);
                const float eb = __expf(bb[j]), e1 = __expf(bb[j] - r31), e2 = __expf(r31 - bb[j]), kk = 1.0f - __expf(lf[j]);
                QDl[i * QS + k] = (bf16)f2bf(qv * eb); QHl[i * QS + k] = (bf16)f2bf(qv * e1); KHl[i * QS + k] = (bf16)f2bf(kk * e2); }
            load_colT(V + (size_t)b * SEQ * D + h * HK, t0, dir, k, ig, VT);
            __syncthreads();
            {
                const int it = wave >> 1;
#pragma unroll
                for (int jj = 0; jj < 2; ++jj) { const int jt = 2 * (wave & 1) + jj;
                    f32x4 a4 = (f32x4){0.f, 0.f, 0.f, 0.f};
                    if (jt <= it) {
#pragma unroll
                        for (int ks = 0; ks < 4; ++ks) { const bfx8 a = *(const LAS bfx8*)(QHl + (16 * it + fr) * QS + 32 * ks + 8 * fq); const bfx8 bt = *(const LAS bfx8*)(KHl + (16 * jt + fr) * QS + 32 * ks + 8 * fq); a4 = MFMA16(bt, a, a4); }
                    }
                    const int ii = 16 * it + fr, j0 = 16 * jt + 4 * fq;
                    const float m0 = (jt <= it && j0 + 0 <= ii) ? a4.x : 0.f, m1 = (jt <= it && j0 + 1 <= ii) ? a4.y : 0.f, m2 = (jt <= it && j0 + 2 <= ii) ? a4.z : 0.f, m3 = (jt <= it && j0 + 3 <= ii) ? a4.w : 0.f;
                    v2u o; o.x = pk2(m0, m1); o.y = pk2(m2, m3); *(LAS v2u*)(AM + ii * TS + j0) = o; }
            }
            __syncthreads();
            {
                const int it = wave & 3, vh = wave >> 2;
                f32x4 o4[4];
#pragma unroll
                for (int n = 0; n < 4; ++n) o4[n] = (f32x4){0.f, 0.f, 0.f, 0.f};
                const bf16* STt = ST + ((size_t)seq * 64 + c) * 16384;
#pragma unroll
                for (int ks = 0; ks < 4; ++ks) { const bfx8 a = *(const LAS bfx8*)(QDl + (16 * it + fr) * QS + 32 * ks + 8 * fq);
#pragma unroll
                    for (int n = 0; n < 4; ++n) { const bfx8 bt = *(const bfx8*)(STt + (64 * vh + 16 * n + fr) * 128 + 32 * ks + 8 * fq); o4[n] = MFMA16(bt, a, o4[n]); } }
#pragma unroll
                for (int ks = 0; ks < 2; ++ks) { const bfx8 a = *(const LAS bfx8*)(AM + (16 * it + fr) * TS + 32 * ks + 8 * fq);
#pragma unroll
                    for (int n = 0; n < 4; ++n) { const bfx8 bt = *(const LAS bfx8*)(VT + (64 * vh + 16 * n + fr) * TS + 32 * ks + 8 * fq); o4[n] = MFMA16(bt, a, o4[n]); } }
                const int i = 16 * it + fr, tl = dir ? 63 - i : i;
#pragma unroll
                for (int n = 0; n < 4; ++n) { LAS f32x4* p = (LAS f32x4*)(OS + tl * OSS + 64 * vh + 16 * n + 4 * fq); if (dir == 0) *p = o4[n]; else *p = *p + o4[n]; }
            }
            __syncthreads();
        }
        {
            const int row = tid >> 3, vseg = tid & 7;
            const LAS f32x4* p = (const LAS f32x4*)(OS + row * OSS + 16 * vseg);
            f32x4 o[4]; float ss = 0.f;
#pragma unroll
            for (int x4 = 0; x4 < 4; ++x4) { o[x4] = p[x4]; ss += (o[x4].x * o[x4].x + o[x4].y * o[x4].y) + (o[x4].z * o[x4].z + o[x4].w * o[x4].w); }
            ss += __shfl_xor(ss, 1); ss += __shfl_xor(ss, 2); ss += __shfl_xor(ss, 4);
            const float r = __builtin_amdgcn_rsqf(ss * (1.f / HK) + EPS);
            const size_t goff = (size_t)(b * SEQ + t0 + row) * D + h * HK + 16 * vseg;
            float g[8], y[8];
#pragma unroll
            for (int hh = 0; hh < 2; ++hh) { unpack8(*(const v4u*)(Gt + goff + 8 * hh), g);
                const f32x4 w0 = *(const f32x4*)(gnw + 16 * vseg + 8 * hh), w1 = *(const f32x4*)(gnw + 16 * vseg + 8 * hh + 4);
                const f32x4 oa = o[2 * hh], ob = o[2 * hh + 1];
                y[0] = oa.x * r * w0.x * g[0]; y[1] = oa.y * r * w0.y * g[1]; y[2] = oa.z * r * w0.z * g[2]; y[3] = oa.w * r * w0.w * g[3];
                y[4] = ob.x * r * w1.x * g[4]; y[5] = ob.y * r * w1.y * g[5]; y[6] = ob.z * r * w1.z * g[6]; y[7] = ob.w * r * w1.w * g[7];
                *(v4u*)(Yo + goff + 8 * hh) = pack8(y); }
        }
    }
}

__device__ __forceinline__ void sconv_phase(const bf16* U, const float* wc, bf16* Y, int gtid, int NT) {
    for (int idx = gtid; idx < M * (D / 8); idx += NT) {
        const int m = idx >> 8, c0 = (idx & 255) * 8, tp = m & (SEQ - 1);
        float w0[8], w1[8], w2[8];
#pragma unroll
        for (int e = 0; e < 8; ++e) { w0[e] = wc[c0 + e]; w1[e] = wc[D + c0 + e]; w2[e] = wc[2 * D + c0 + e]; }
        const bf16* r = U + (size_t)m * N_SC + c0;
        float gb[8], c[8], x[8], z[8];
        unpack8(*(const v4u*)(r), gb); unpack8(*(const v4u*)(r + D), c); unpack8(*(const v4u*)(r + 2 * D), x);
#pragma unroll
        for (int e = 0; e < 8; ++e) z[e] = w1[e] * (c[e] * x[e]);
        if (tp > 0) { unpack8(*(const v4u*)(r - N_SC + D), c); unpack8(*(const v4u*)(r - N_SC + 2 * D), x);
#pragma unroll
            for (int e = 0; e < 8; ++e) z[e] += w0[e] * (c[e] * x[e]); }
        if (tp < SEQ - 1) { unpack8(*(const v4u*)(r + N_SC + D), c); unpack8(*(const v4u*)(r + N_SC + 2 * D), x);
#pragma unroll
            for (int e = 0; e < 8; ++e) z[e] += w2[e] * (c[e] * x[e]); }
#pragma unroll
        for (int e = 0; e < 8; ++e) z[e] *= gb[e];
        *(v4u*)(Y + (size_t)m * D + c0) = pack8(z);
    }
}

__device__ __forceinline__ void ffnact_phase(const bf16* UP, const float* wc, bf16* ACT, int gtid, int NT) {
    constexpr int CB = FF / 8;
    for (int idx = gtid; idx < M * CB; idx += NT) {
        const int m = idx / CB, c0 = (idx - m * CB) * 8, tp = m & (SEQ - 1);
        const bf16* r = UP + (size_t)m * N_FI + c0;
        float g[8], v[8], a[8], b[8];
        unpack8(*(const v4u*)(r), a); unpack8(*(const v4u*)(r + FF), b);
#pragma unroll
        for (int e = 0; e < 8; ++e) { g[e] = wc[N_FI + c0 + e] * a[e]; v[e] = wc[N_FI + FF + c0 + e] * b[e]; }
        if (tp > 0) { unpack8(*(const v4u*)(r - N_FI), a); unpack8(*(const v4u*)(r - N_FI + FF), b);
#pragma unroll
            for (int e = 0; e < 8; ++e) { g[e] += wc[c0 + e] * a[e]; v[e] += wc[FF + c0 + e] * b[e]; } }
        if (tp < SEQ - 1) { unpack8(*(const v4u*)(r + N_FI), a); unpack8(*(const v4u*)(r + N_FI + FF), b);
#pragma unroll
            for (int e = 0; e < 8; ++e) { g[e] += wc[2 * N_FI + c0 + e] * a[e]; v[e] += wc[2 * N_FI + FF + c0 + e] * b[e]; } }
#pragma unroll
        for (int e = 0; e < 8; ++e) g[e] = g[e] * fsig(g[e]) * v[e];
        *(v4u*)(ACT + (size_t)m * FF + c0) = pack8(g);
    }
}

struct Args { const float* in[15]; float* out; unsigned char* ws; int ph_lo, ph_hi; };
constexpr int N_PHASES = 1 + 2 * 10 + 2 * 8;

template <class Epi>
__device__ __forceinline__ void run_gemm(LAS unsigned char* lds, const bf16* A, const bf16* Bt, int N, int K, const Epi& E) {
    pg8::Gemm g{A, Bt, M, N, K}; pg8::StaticOrder S; S.init(M, N, (int)gridDim.x, (int)blockIdx.x);
    pg8::gemm_phase<Epi, pg8::StaticOrder, true, true>(lds, g, S, E);
}

__global__ void __launch_bounds__(NTHR, 2) mega_fwd(Args args) {
    extern __shared__ __attribute__((aligned(16))) unsigned char lds_raw[];
    LAS unsigned char* lds = (LAS unsigned char*)lds_raw;
    cg::grid_group grid = cg::this_grid();
    const int lo = args.ph_lo, hi = args.ph_hi;
    int ph = 0;
#define PH_BEGIN if (ph >= lo && ph < hi) { \
    int tid = threadIdx.x; asm volatile("" : "+v"(tid)); \
    const int lane = tid & 63, wave = __builtin_amdgcn_readfirstlane(tid >> 6); \
    const int G = gridDim.x, gw = blockIdx.x * NWAVES + wave, NGW = G * NWAVES, gtid = blockIdx.x * NTHR + tid, NT = G * NTHR; \
    unsigned char* ws = args.ws; asm volatile("" : "+s"(ws)); \
    (void)lane; (void)gw; (void)NGW; (void)gtid; (void)NT;
#define PH_END } ++ph; if (ph - 1 >= lo && ph < hi) grid.sync();
#define x_in args.in[0]
#define hg_w_in args.in[1]
#define hg_w_out args.in[2]
#define hg_gn args.in[3]
#define hg_lb args.in[4]
#define sc_w_in args.in[5]
#define sc_w_conv args.in[6]
#define sc_w_out args.in[7]
#define ff_w_in args.in[8]
#define ff_w_conv args.in[9]
#define ff_w_out args.in[10]
#define n_pre_mix args.in[11]
#define n_post_mix args.in[12]
#define n_pre_ffn args.in[13]
#define n_post_ffn args.in[14]
#define WHGI ((bf16*)(ws + WS_WHGI))
#define WHGO ((bf16*)(ws + WS_WHGO))
#define WSCI ((bf16*)(ws + WS_WSCI))
#define WSCO ((bf16*)(ws + WS_WSCO))
#define WFI ((bf16*)(ws + WS_WFI))
#define WFO ((bf16*)(ws + WS_WFO))
#define X ((float*)(ws + WS_X))
#define XN ((bf16*)(ws + WS_XN))
#define MB ((float*)(ws + WS_MBUF))
#define U (ws + WS_U)
#define ACT ((bf16*)(ws + WS_ACT))
#define Y ((bf16*)(ws + WS_ACT))
#define Qb ((bf16*)(ws + WS_U + U_Q))
#define Vb ((bf16*)(ws + WS_U + U_V))
#define Gb ((bf16*)(ws + WS_U + U_G))
#define LFf ((float*)(ws + WS_U + U_LFF))
#define LFb ((float*)(ws + WS_U + U_LFB))
#define Of ((float*)(ws + WS_REC))
#define Ob ((float*)(ws + WS_REC + 64 * MiB))

    PH_BEGIN
        LAS float* scr = (LAS float*)(lds + wave * 16384);
        for (int j = 0; j < 2; ++j) {
            transpose_matrix(hg_w_in + (size_t)j * D * N_HG, D, N_HG, WHGI + (size_t)j * N_HG * D, scr, gw, NGW, lane);
            transpose_matrix(hg_w_out + (size_t)j * D * D, D, D, WHGO + (size_t)j * D * D, scr, gw, NGW, lane);
            transpose_matrix(sc_w_in + (size_t)j * D * N_SC, D, N_SC, WSCI + (size_t)j * N_SC * D, scr, gw, NGW, lane);
            transpose_matrix(sc_w_out + (size_t)j * D * D, D, D, WSCO + (size_t)j * D * D, scr, gw, NGW, lane);
        }
        for (int i = 0; i < DEPTH; ++i) {
            transpose_matrix(ff_w_in + (size_t)i * D * N_FI, D, N_FI, WFI + (size_t)i * N_FI * D, scr, gw, NGW, lane);
            transpose_matrix(ff_w_out + (size_t)i * FF * D, FF, D, WFO + (size_t)i * D * FF, scr, gw, NGW, lane);
        }
        rownorm_phase(x_in, nullptr, nullptr, n_pre_mix, X, XN, gw, NGW, lane);
    PH_END

    for (int i = 0; i < DEPTH; ++i) {
        const int j = i >> 1;
        if ((i & 1) == 0) {
            PH_BEGIN
                pg8::EpiHgrn E{U, hg_lb, j};
                run_gemm(lds, XN, WHGI + (size_t)j * N_HG * D, N_HG, D, E);
            PH_END
            PH_BEGIN
                rec_pass1(lds, Vb, LFf, LFb, (float*)(ws + WS_REC + REC_UT), (float*)(ws + WS_REC + REC_DEC), tid);
            PH_END
            PH_BEGIN
                rec_pass2((const float*)(ws + WS_REC + REC_UT), (const float*)(ws + WS_REC + REC_DEC), (bf16*)(ws + WS_REC + REC_ST), gtid, NT);
            PH_END
            PH_BEGIN
                rec_pass3(lds, Qb, Vb, Gb, LFf, LFb, (const bf16*)(ws + WS_REC + REC_ST), hg_gn + (size_t)j * HK, Y, tid);
            PH_END
            PH_BEGIN
                pg8::EpiF32 E{MB, D};
                run_gemm(lds, Y, WHGO + (size_t)j * D * D, D, D, E);
            PH_END
        } else {
            PH_BEGIN
                pg8::EpiBf16 E{(bf16*)U, N_SC};
                run_gemm(lds, XN, WSCI + (size_t)j * N_SC * D, N_SC, D, E);
            PH_END
            PH_BEGIN
                sconv_phase((const bf16*)U, sc_w_conv + (size_t)j * 3 * D, Y, gtid, NT);
            PH_END
            PH_BEGIN
                pg8::EpiF32 E{MB, D};
                run_gemm(lds, Y, WSCO + (size_t)j * D * D, D, D, E);
            PH_END
        }
        PH_BEGIN
            rownorm_phase(X, MB, n_post_mix + (size_t)i * D, n_pre_ffn + (size_t)i * D, X, XN, gw, NGW, lane);
        PH_END
        PH_BEGIN
            pg8::EpiBf16 E{(bf16*)U, N_FI};
            run_gemm(lds, XN, WFI + (size_t)i * N_FI * D, N_FI, D, E);
        PH_END
        PH_BEGIN
            ffnact_phase((const bf16*)U, ff_w_conv + (size_t)i * 3 * N_FI, ACT, gtid, NT);
        PH_END
        PH_BEGIN
            pg8::EpiF32 E{MB, D};
            run_gemm(lds, ACT, WFO + (size_t)i * D * FF, D, FF, E);
        PH_END
        PH_BEGIN
            if (i == DEPTH - 1) rownorm_phase(X, MB, n_post_ffn + (size_t)i * D, nullptr, args.out, nullptr, gw, NGW, lane);
            else rownorm_phase(X, MB, n_post_ffn + (size_t)i * D, n_pre_mix + (size_t)(i + 1) * D, X, XN, gw, NGW, lane);
        PH_END
    }
#undef PH_BEGIN
#undef PH_END
#undef X
#undef Y
#undef U
}

#ifndef MK_MULTI
#define MK_MULTI 0
#endif
extern "C" void kernel_launch(void* const* d_in, const int* in_sizes, int n_in, void* d_out, int out_size, void* d_ws, size_t ws_size, hipStream_t stream) {
    static int grid = 0;
    if (grid == 0) {
        if (n_in != 15 || out_size != M * D || ws_size < WS_END) { fprintf(stderr, "kernel_launch: unexpected shapes (n_in %d out %d ws %zu)\n", n_in, out_size, ws_size); grid = -1; return; }
        int dev = 0, cus = 0, per_cu = 0;
        hipGetDevice(&dev); hipDeviceGetAttribute(&cus, hipDeviceAttributeMultiprocessorCount, dev);
        if (hipFuncSetAttribute((const void*)mega_fwd, hipFuncAttributeMaxDynamicSharedMemorySize, LDS_BYTES) != hipSuccess) { fprintf(stderr, "hipFuncSetAttribute failed\n"); grid = -1; return; }
        if (hipOccupancyMaxActiveBlocksPerMultiprocessor(&per_cu, (const void*)mega_fwd, NTHR, LDS_BYTES) != hipSuccess || per_cu < 1) { fprintf(stderr, "occupancy query: %d\n", per_cu); per_cu = 1; }
        (void)hipGetLastError();
        grid = cus * 1;
    }
    if (grid < 0) return;
    Args a{};
    for (int i = 0; i < 15; ++i) a.in[i] = (const float*)d_in[i];
    a.out = (float*)d_out; a.ws = (unsigned char*)d_ws;
#if MK_MULTI
    for (int p = 0; p < N_PHASES; ++p) { a.ph_lo = p; a.ph_hi = p + 1; hipLaunchKernelGGL(mega_fwd, dim3(grid), dim3(NTHR), LDS_BYTES, stream, a); }
#else
    a.ph_lo = 0; a.ph_hi = N_PHASES;
    void* kargs[] = {&a};
    hipError_t e = hipLaunchCooperativeKernel((const void*)mega_fwd, dim3(grid), dim3(NTHR), kargs, LDS_BYTES, stream);
    if (e != hipSuccess) fprintf(stderr, "cooperative launch failed: %s (grid %d)\n", hipGetErrorString(e), grid);
#endif
}
```

```cpp
#include <hip/hip_runtime.h>
#include <hip/hip_cooperative_groups.h>
#include <cstdio>
#include <cstdint>
namespace cg = cooperative_groups;
namespace pg8 {
#define PG8_LAS __attribute__((address_space(3)))
typedef unsigned short bf16_t;
typedef short bf16x8 __attribute__((ext_vector_type(8)));
typedef float f32x4 __attribute__((ext_vector_type(4)));
typedef unsigned u32x4 __attribute__((ext_vector_type(4)));
constexpr int BM = 256, BK = 64, HALF = 128, HTB = HALF * BK * 2  , STAGE_BYTES = 8 * HTB, NXCD = 8, WGM = 8;

__host__ __device__ __forceinline__ int lds_byte(int r, int c) { const int st = (r >> 4) * 2 + (c >> 5), rr = r & 15, cc = c & 31, ob = rr * 64 + cc * 2; return st * 1024 + (ob ^ (((ob >> 9) & 1) << 5)); }
__host__ __device__ __forceinline__ void stage_rc(int b, int& R, int& C) { const int st = b / 1024, sb = b % 1024, swz = sb ^ (((sb >> 9) & 1) << 5); R = (st >> 1) * 16 + swz / 64; C = (st & 1) * 32 + (swz % 64) / 2; }
__host__ __device__ __forceinline__ int perm32(int rho) { const int n = rho >> 4, i = rho & 15; return 8 * (i >> 2) + 4 * n + (i & 3); }

struct Unit { int pm, pn; };
struct Gemm { const bf16_t* A; const bf16_t* Bt; int M, N, K; };

struct StaticOrder {
    int nM, nN, nwg, G, c;
    __host__ __device__ void init(int M, int N, int G_, int c_) { nM = M / BM; nN = N / BM; nwg = nM * nN; G = G_; c = c_; }
    __host__ __device__ bool next(int i, Unit& u) const {
        const long L = (long)i * G + c; if (L >= nwg) return false;
        int wgid = (int)L; { const int q = nwg / NXCD, r = nwg % NXCD, xcd = wgid % NXCD, off = wgid / NXCD; wgid = (xcd < r ? xcd * (q + 1) : r * (q + 1) + (xcd - r) * q) + off; }
        const int nig = WGM * nN, gid = wgid / nig, fm = gid * WGM, gsz = (nM - fm) < WGM ? (nM - fm) : WGM;
        u.pm = fm + ((wgid % nig) % gsz); u.pn = (wgid % nig) / gsz; return true;
    }
    __device__ __forceinline__ void a_ready(const Unit&) const {}
    __device__ __forceinline__ void done(const Unit&) const {}
};
__device__ __forceinline__ unsigned cvt_pk_bf16(float lo, float hi) { unsigned r; asm volatile("v_cvt_pk_bf16_f32 %0, %1, %2" : "=v"(r) : "v"(lo), "v"(hi)); return r; }
typedef float f32x2 __attribute__((ext_vector_type(2)));
template <class Epi, class Sched, bool ALIGN_EPI = false, bool SP2 = false>
__device__ __forceinline__ void gemm_phase(PG8_LAS unsigned char* lds, const Gemm g, const Sched& S, const Epi& E) {
    int tid_o = threadIdx.x; asm volatile("" : "+v"(tid_o));
    const int tid = tid_o, wid = __builtin_amdgcn_readfirstlane(tid >> 6), lane = tid & 63, wr = wid >> 2, wc = wid & 3, fr = lane & 15, fq = lane >> 4;
    const int K = g.K, nt = K / BK;
    unsigned voffA[2], voffB[2];
#pragma unroll
    for (int i = 0; i < 2; ++i) { int R, C; stage_rc(tid * 16 + i * 8192, R, C); const int Rb = Epi::PERM ? ((R & ~31) + perm32(R & 31)) : R;
        voffA[i] = (unsigned)(R * K + C) * 2u; voffB[i] = (unsigned)(Rb * K + C) * 2u; }
    const size_t kstep = (size_t)(BK * 2);
    const size_t hstep = (size_t)HALF * K * 2;
    const size_t tstep = 2 * hstep;
    const unsigned ldsw = (unsigned)wid * 1024u;
    const int aoff = lds_byte(wr * 64 + fr, fq * 8), boff = lds_byte(wc * 32 + fr, fq * 8);
#define PG8_SA(b, h) (((b) * 2 + (h)) * HTB)
#define PG8_SB(b, h) ((4 + (b) * 2 + (h)) * HTB)
#define PG8_STAGE(bufoff, gbase, voff) do { _Pragma("unroll") for (int _i = 0; _i < 2; ++_i) \
        __builtin_amdgcn_global_load_lds((const unsigned*)((const char*)(gbase) + (voff)[_i]), (PG8_LAS unsigned*)(lds + (bufoff) + ldsw + _i * 8192), 16, 0, 0); } while (0)
#define PG8_LDA(dst, b, h) do { _Pragma("unroll") for (int m = 0; m < 4; ++m) _Pragma("unroll") for (int k = 0; k < 2; ++k) dst[m][k] = *(const PG8_LAS bf16x8*)(lds + PG8_SA(b, h) + aoff + m * 2048 + k * 1024); } while (0)
#define PG8_LDB(dst, b, h) do { _Pragma("unroll") for (int n = 0; n < 2; ++n) _Pragma("unroll") for (int k = 0; k < 2; ++k) dst[n][k] = *(const PG8_LAS bf16x8*)(lds + PG8_SB(b, h) + boff + n * 2048 + k * 1024); } while (0)
#define PG8_MMA(ai, bj, At, Bt) do { __builtin_amdgcn_s_setprio(1); _Pragma("unroll") for (int m = 0; m < 4; ++m) _Pragma("unroll") for (int n = 0; n < 2; ++n) _Pragma("unroll") for (int k = 0; k < 2; ++k) \
        acc[ai][bj][m][n] = __builtin_amdgcn_mfma_f32_16x16x32_bf16(Bt[n][k], At[m][k], acc[ai][bj][m][n], 0, 0, 0); __builtin_amdgcn_s_setprio(0); } while (0)
#define PG8_WAIT_V(n) asm volatile("s_waitcnt vmcnt(" #n ")" ::: "memory")
#define PG8_WAIT_L(n) asm volatile("s_waitcnt lgkmcnt(" #n ")" ::: "memory")
#define PG8_BAR __builtin_amdgcn_s_barrier()
#define PG8_SCHED __builtin_amdgcn_sched_barrier(0)
    Unit cur, nxt; int ui = 0;
    if (!S.next(0, cur)) return;
    f32x4 acc[2][2][4][2];
#pragma unroll
    for (int a = 0; a < 2; ++a)
#pragma unroll
        for (int b = 0; b < 2; ++b)
#pragma unroll
            for (int m = 0; m < 4; ++m)
#pragma unroll
                for (int n = 0; n < 2; ++n) acc[a][b][m][n] = (f32x4){0.f, 0.f, 0.f, 0.f};
    bf16x8 At[4][2], B0[2][2], B1[2][2];
    const char* cA = (const char*)g.A + (size_t)cur.pm * tstep; const char* cB = (const char*)g.Bt + (size_t)cur.pn * tstep;
    S.a_ready(cur);
    if constexpr (SP2) {
        PG8_STAGE(PG8_SB(0, 0), cB, voffB); PG8_STAGE(PG8_SB(0, 1), cB + hstep, voffB); PG8_STAGE(PG8_SA(0, 0), cA, voffA); PG8_STAGE(PG8_SA(0, 1), cA + hstep, voffA);
        if (wr == 1) PG8_BAR;
        PG8_WAIT_V(2); PG8_BAR;
        PG8_STAGE(PG8_SB(1, 0), cB + kstep, voffB); PG8_STAGE(PG8_SA(1, 0), cA + kstep, voffA); PG8_STAGE(PG8_SB(1, 1), cB + hstep + kstep, voffB);
        PG8_WAIT_V(6); PG8_BAR;
    } else {
        PG8_STAGE(PG8_SB(0, 0), cB, voffB); PG8_STAGE(PG8_SA(0, 0), cA, voffA); PG8_STAGE(PG8_SB(0, 1), cB + hstep, voffB); PG8_STAGE(PG8_SA(0, 1), cA + hstep, voffA);
        if (wr == 1) PG8_BAR;
        PG8_WAIT_V(4); PG8_BAR;
        PG8_STAGE(PG8_SB(1, 0), cB + kstep, voffB); PG8_STAGE(PG8_SA(1, 0), cA + kstep, voffA); PG8_STAGE(PG8_SB(1, 1), cB + hstep + kstep, voffB);
        PG8_WAIT_V(6); PG8_BAR;
    }
    for (;;) {
        const bool has_next = S.next(ui + 1, nxt);
        const char* nA = has_next ? (const char*)g.A + (size_t)nxt.pm * tstep : cA; const char* nB = has_next ? (const char*)g.Bt + (size_t)nxt.pn * tstep : cB;
        for (int t = 0; t < nt; t += 2) {
            const bool last = (t == nt - 2);
            const char* a1 = cA + (size_t)(t + 1) * kstep;
            const char* a2 = last ? nA : cA + (size_t)(t + 2) * kstep; const char* b2 = last ? nB : cB + (size_t)(t + 2) * kstep;
            const char* a3 = a2 + kstep; const char* b3 = b2 + kstep;
            if (last && has_next) S.a_ready(nxt);
            if constexpr (SP2) {
            PG8_LDB(B0, 0, 0); PG8_LDB(B1, 0, 1); PG8_SCHED; PG8_LDA(At, 0, 0); PG8_STAGE(PG8_SA(1, 1), a1 + hstep, voffA);
            PG8_WAIT_V(8); PG8_WAIT_L(0); PG8_BAR; PG8_MMA(0, 0, At, B0); PG8_MMA(0, 1, At, B1); PG8_BAR; PG8_SCHED;
            PG8_LDA(At, 0, 1); PG8_STAGE(PG8_SB(0, 0), b2, voffB); PG8_STAGE(PG8_SB(0, 1), b2 + hstep, voffB); PG8_STAGE(PG8_SA(0, 0), a2, voffA);
            PG8_WAIT_V(8); PG8_WAIT_L(0); PG8_BAR; PG8_MMA(1, 0, At, B0); PG8_MMA(1, 1, At, B1); PG8_BAR; PG8_SCHED;
            PG8_LDB(B0, 1, 0); PG8_LDB(B1, 1, 1); PG8_SCHED; PG8_LDA(At, 1, 0); PG8_STAGE(PG8_SA(0, 1), a2 + hstep, voffA);
            PG8_WAIT_V(8); PG8_WAIT_L(0); PG8_BAR; PG8_MMA(0, 0, At, B0); PG8_MMA(0, 1, At, B1); PG8_BAR; PG8_SCHED;
            PG8_LDA(At, 1, 1); PG8_STAGE(PG8_SB(1, 0), b3, voffB); PG8_STAGE(PG8_SB(1, 1), b3 + hstep, voffB); PG8_STAGE(PG8_SA(1, 0), a3, voffA);
            PG8_WAIT_V(8); PG8_WAIT_L(0); PG8_BAR; PG8_MMA(1, 0, At, B0); PG8_MMA(1, 1, At, B1); PG8_BAR; PG8_SCHED;
            } else {
            PG8_LDB(B0, 0, 0); PG8_SCHED; PG8_LDA(At, 0, 0); PG8_STAGE(PG8_SA(1, 1), a1 + hstep, voffA);
            PG8_WAIT_L(8); PG8_BAR; PG8_WAIT_L(0); PG8_MMA(0, 0, At, B0); PG8_BAR; PG8_SCHED;
            PG8_LDB(B1, 0, 1); PG8_STAGE(PG8_SB(0, 0), b2, voffB);
            PG8_BAR; PG8_WAIT_L(0); PG8_MMA(0, 1, At, B1); PG8_BAR;
            PG8_LDA(At, 0, 1); PG8_STAGE(PG8_SA(0, 0), a2, voffA);
            PG8_BAR; PG8_WAIT_L(0); PG8_MMA(1, 0, At, B0); PG8_BAR; PG8_SCHED;
            PG8_STAGE(PG8_SB(0, 1), b2 + hstep, voffB);
            PG8_WAIT_V(6); PG8_BAR; PG8_MMA(1, 1, At, B1); PG8_BAR;
            PG8_LDB(B0, 1, 0); PG8_SCHED; PG8_LDA(At, 1, 0); PG8_STAGE(PG8_SA(0, 1), a2 + hstep, voffA);
            PG8_WAIT_L(8); PG8_BAR; PG8_WAIT_L(0); PG8_MMA(0, 0, At, B0); PG8_BAR; PG8_SCHED;
            PG8_LDB(B1, 1, 1); PG8_STAGE(PG8_SB(1, 0), b3, voffB);
            PG8_BAR; PG8_WAIT_L(0); PG8_MMA(0, 1, At, B1); PG8_BAR;
            PG8_LDA(At, 1, 1); PG8_STAGE(PG8_SA(1, 0), a3, voffA);
            PG8_BAR; PG8_WAIT_L(0); PG8_MMA(1, 0, At, B0); PG8_BAR; PG8_SCHED;
            PG8_STAGE(PG8_SB(1, 1), b3 + hstep, voffB);
            PG8_WAIT_V(6); PG8_BAR; PG8_MMA(1, 1, At, B1); PG8_BAR;
            }
        }
        if constexpr (ALIGN_EPI) { if (wr == 0) PG8_BAR; }
        if constexpr (!Epi::AFTER_DRAIN) { E(acc, cur, wr, wc, fr, fq); S.done(cur); }
        if (!has_next) break;
#pragma unroll
        for (int a = 0; a < 2; ++a)
#pragma unroll
            for (int b = 0; b < 2; ++b)
#pragma unroll
                for (int m = 0; m < 4; ++m)
#pragma unroll
                    for (int n = 0; n < 2; ++n) acc[a][b][m][n] = (f32x4){0.f, 0.f, 0.f, 0.f};
        cur = nxt; cA = nA; cB = nB; ++ui;
        if constexpr (ALIGN_EPI) { if (wr == 1) PG8_BAR; }
    }
    PG8_WAIT_V(0);
    if constexpr (!ALIGN_EPI) { if (wr == 0) PG8_BAR; }
    PG8_BAR;
    if constexpr (Epi::AFTER_DRAIN) { E.fused(acc, cur, wr, wc, fr, fq, lds, wid, lane); S.done(cur); }
#undef PG8_SA
#undef PG8_SB
#undef PG8_STAGE
#undef PG8_LDA
#undef PG8_LDB
#undef PG8_MMA
#undef PG8_WAIT_V
#undef PG8_WAIT_L
#undef PG8_BAR
#undef PG8_SCHED
}
}
namespace pg8 {
__device__ __forceinline__ float fsigmoid(float x) { return __builtin_amdgcn_rcpf(1.0f + __expf(-x)); }
struct EpiF32 {
    static constexpr bool PERM = false, AFTER_DRAIN = false;
    float* C; int ldc;
    __device__ __forceinline__ void operator()(const f32x4 (&acc)[2][2][4][2], const Unit& u, int wr, int wc, int fr, int fq) const {
        const int row0 = u.pm * BM + wr * 64 + fr, col0 = u.pn * BM + wc * 32 + 4 * fq;
#pragma unroll
        for (int ai = 0; ai < 2; ++ai)
#pragma unroll
            for (int m = 0; m < 4; ++m) { float* rowp = C + (size_t)(row0 + ai * HALF + m * 16) * ldc + col0;
#pragma unroll
                for (int bj = 0; bj < 2; ++bj)
#pragma unroll
                    for (int n = 0; n < 2; ++n) *(f32x4*)(rowp + bj * HALF + n * 16) = acc[ai][bj][m][n]; }
    }
};
struct EpiBf16 {
    static constexpr bool PERM = true, AFTER_DRAIN = false;
    bf16_t* O; int ldc;
    __device__ __forceinline__ void operator()(const f32x4 (&acc)[2][2][4][2], const Unit& u, int wr, int wc, int fr, int fq) const {
        const int row0 = u.pm * BM + wr * 64 + fr, col0 = u.pn * BM + wc * 32 + 8 * fq;
#pragma unroll
        for (int ai = 0; ai < 2; ++ai)
#pragma unroll
            for (int m = 0; m < 4; ++m) { bf16_t* rowp = O + (size_t)(row0 + ai * HALF + m * 16) * ldc + col0;
#pragma unroll
                for (int bj = 0; bj < 2; ++bj) { const f32x4 v0 = acc[ai][bj][m][0], v1 = acc[ai][bj][m][1];
                    u32x4 w; w.x = cvt_pk_bf16(v0[0], v0[1]); w.y = cvt_pk_bf16(v0[2], v0[3]); w.z = cvt_pk_bf16(v1[0], v1[1]); w.w = cvt_pk_bf16(v1[2], v1[3]);
                    *(u32x4*)(rowp + bj * HALF) = w; } }
    }
};
struct EpiHgrn {
    static constexpr bool PERM = true, AFTER_DRAIN = false;
    unsigned char* Ub; const float* lbs; int layer_j;
    __device__ __forceinline__ void operator()(const f32x4 (&acc)[2][2][4][2], const Unit& u, int wr, int wc, int fr, int fq) const {
        const int seg = u.pn >> 3, colt = (u.pn & 7) * BM;
        const int row0 = u.pm * BM + wr * 64 + fr, col0 = colt + wc * 32 + 8 * fq;
        if (seg == 1 || seg == 2) {
            const int dir = seg - 1; float* LF = (float*)(Ub + ((size_t)(96 + 64 * dir) << 20));
#pragma unroll
            for (int bj = 0; bj < 2; ++bj) {
                float lb[8];
#pragma unroll
                for (int e = 0; e < 8; ++e) lb[e] = 0.f;
                if (layer_j == 1) {
                    const f32x4 a0 = *(const f32x4*)(lbs + (size_t)(dir * 2 + 0) * 2048 + col0 + bj * HALF), a1 = *(const f32x4*)(lbs + (size_t)(dir * 2 + 0) * 2048 + col0 + bj * HALF + 4);
                    const f32x4 b0 = *(const f32x4*)(lbs + (size_t)(dir * 2 + 1) * 2048 + col0 + bj * HALF), b1 = *(const f32x4*)(lbs + (size_t)(dir * 2 + 1) * 2048 + col0 + bj * HALF + 4);
#pragma unroll
                    for (int e = 0; e < 4; ++e) { lb[e] = fsigmoid(b0[e] - a0[e]); lb[4 + e] = fsigmoid(b1[e] - a1[e]); }
                }
#pragma unroll
                for (int ai = 0; ai < 2; ++ai)
#pragma unroll
                    for (int m = 0; m < 4; ++m) { float* rowp = LF + (size_t)(row0 + ai * HALF + m * 16) * 2048 + col0 + bj * HALF;
#pragma unroll
                        for (int n = 0; n < 2; ++n) { f32x4 o;
#pragma unroll
                            for (int e = 0; e < 4; ++e) { const float s = fsigmoid(acc[ai][bj][m][n][e]); const float l = lb[4 * n + e]; o[e] = __logf(l + (1.0f - l) * s); }
                            *(f32x4*)(rowp + 4 * n) = o; } }
            }
        } else {
            const int sel = (seg == 0) ? 0 : ((seg == 3) ? 1 : 2); bf16_t* O = (bf16_t*)(Ub + ((size_t)(32 * sel) << 20)); const bool act = (seg != 3);
#pragma unroll
            for (int ai = 0; ai < 2; ++ai)
#pragma unroll
                for (int m = 0; m < 4; ++m) { bf16_t* rowp = O + (size_t)(row0 + ai * HALF + m * 16) * 2048 + col0;
#pragma unroll
                    for (int bj = 0; bj < 2; ++bj) { f32x4 v0 = acc[ai][bj][m][0], v1 = acc[ai][bj][m][1];
                        if (act) {
#pragma unroll
                            for (int e = 0; e < 4; ++e) { v0[e] = v0[e] * fsigmoid(v0[e]); v1[e] = v1[e] * fsigmoid(v1[e]); } }
                        u32x4 w; w.x = cvt_pk_bf16(v0[0], v0[1]); w.y = cvt_pk_bf16(v0[2], v0[3]); w.z = cvt_pk_bf16(v1[0], v1[1]); w.w = cvt_pk_bf16(v1[2], v1[3]);
                        *(u32x4*)(rowp + bj * HALF) = w; } }
        }
    }
};
}
#define GAS __attribute__((address_space(1)))
#define LAS __attribute__((address_space(3)))
typedef unsigned short bf16;
typedef unsigned v4u __attribute__((ext_vector_type(4)));
typedef unsigned v2u __attribute__((ext_vector_type(2)));
typedef float f32x4 __attribute__((ext_vector_type(4)));
typedef short bf16x8 __attribute__((ext_vector_type(8)));
constexpr int NWAVES = 8, NTHR = 512;
constexpr int D = 2048, BATCH = 2, SEQ = 4096, M = BATCH * SEQ, DEPTH = 4, NH = 16, HK = 128, FF = 5632;
constexpr int N_HG = 5 * D, N_SC = 3 * D, N_FI = 2 * FF;
constexpr float EPS = 1e-6f;
constexpr size_t MiB = 1u << 20;
constexpr size_t WS_CTL = 0, WS_WHGI = 2 * MiB, WS_WHGO = 82 * MiB, WS_WSCI = 98 * MiB, WS_WSCO = 146 * MiB, WS_WFI = 162 * MiB, WS_WFO = 338 * MiB;
constexpr size_t WS_X = 426 * MiB, WS_XN = 490 * MiB, WS_MBUF = 522 * MiB, WS_U = 586 * MiB, WS_ACT = 810 * MiB, WS_REC = 898 * MiB, WS_END = 1286 * MiB;
constexpr size_t U_Q = 0, U_V = 32 * MiB, U_G = 64 * MiB, U_LFF = 96 * MiB, U_LFB = 160 * MiB;
constexpr int LDS_BYTES = 147456;

__device__ __forceinline__ unsigned f2bf(float f) { unsigned u = __builtin_bit_cast(unsigned, f); return (u + 0x7fffu + ((u >> 16) & 1u)) >> 16; }
__device__ __forceinline__ unsigned pk2(float lo, float hi) { return f2bf(lo) | (f2bf(hi) << 16); }
__device__ __forceinline__ float bflo(unsigned w) { return __builtin_bit_cast(float, w << 16); }
__device__ __forceinline__ float bfhi(unsigned w) { return __builtin_bit_cast(float, w & 0xffff0000u); }
__device__ __forceinline__ float bf2f(bf16 b) { return __builtin_bit_cast(float, ((unsigned)b) << 16); }
__device__ __forceinline__ float wave_sum(float v) {
#pragma unroll
    for (int o = 1; o < 64; o <<= 1) v += __shfl_xor(v, o);
    return v;
}
__device__ __forceinline__ float fsig(float x) { return __builtin_amdgcn_rcpf(1.0f + __expf(-x)); }
#define LDS_WAIT() asm volatile("s_waitcnt lgkmcnt(0)" ::: "memory")

__device__ __forceinline__ void p0_transpose_item(const float* W, int K, int N, bf16* WT, LAS float* scr, int item, int lane) {
    const int nblk = N / 32, kb = item / nblk, nb = item % nblk, k0 = 64 * kb, n0 = 32 * nb;
#pragma unroll 8
    for (int i = 0; i < 32; ++i) { const int kk = 2 * i + (lane >> 5); scr[kk * 33 + (lane & 31)] = W[(size_t)(k0 + kk) * N + n0 + (lane & 31)]; }
    LDS_WAIT(); asm volatile("" ::: "memory");
    const int c = lane & 7;
#pragma unroll
    for (int j = 0; j < 4; ++j) { const int n = (lane >> 3) + 8 * j; const LAS float* s = scr + (8 * c) * 33 + n;
        v4u o; o.x = pk2(s[0 * 33], s[1 * 33]); o.y = pk2(s[2 * 33], s[3 * 33]); o.z = pk2(s[4 * 33], s[5 * 33]); o.w = pk2(s[6 * 33], s[7 * 33]);
        *(v4u*)(WT + (size_t)(n0 + n) * K + k0 + 8 * c) = o; }
    LDS_WAIT(); asm volatile("" ::: "memory");
}
__device__ __forceinline__ void transpose_matrix(const float* W, int K, int N, bf16* WT, LAS float* scr, int gw, int NGW, int lane) {
    const int items = (K / 64) * (N / 32);
    for (int it = gw; it < items; it += NGW) p0_transpose_item(W, K, N, WT, scr, it, lane);
}

__device__ __forceinline__ void rownorm_phase(const float* xin, const float* mb, const float* w_post, const float* w_next, float* xout, bf16* xn, int gw, int NGW, int lane) {
    for (int m = gw; m < M; m += NGW) {
        const f32x4* xr = (const f32x4*)(xin + (size_t)m * D) + lane;
        f32x4 x[8];
#pragma unroll
        for (int j = 0; j < 8; ++j) x[j] = xr[64 * j];
        if (mb) {
            const f32x4* mr = (const f32x4*)(mb + (size_t)m * D) + lane;
            f32x4 mm[8]; float ss = 0.f;
#pragma unroll
            for (int j = 0; j < 8; ++j) { mm[j] = mr[64 * j]; ss += (mm[j].x * mm[j].x + mm[j].y * mm[j].y) + (mm[j].z * mm[j].z + mm[j].w * mm[j].w); }
            const float rstd = __builtin_amdgcn_rsqf(wave_sum(ss) * (1.f / D) + EPS);
#pragma unroll
            for (int j = 0; j < 8; ++j) { const f32x4 w = ((const f32x4*)w_post)[lane + 64 * j]; x[j] = x[j] + mm[j] * rstd * w; }
        }
        if (xout) { f32x4* o = (f32x4*)(xout + (size_t)m * D) + lane;
#pragma unroll
            for (int j = 0; j < 8; ++j) o[64 * j] = x[j]; }
        if (xn) {
            float s2 = 0.f;
#pragma unroll
            for (int j = 0; j < 8; ++j) s2 += (x[j].x * x[j].x + x[j].y * x[j].y) + (x[j].z * x[j].z + x[j].w * x[j].w);
            const float r2 = __builtin_amdgcn_rsqf(wave_sum(s2) * (1.f / D) + EPS);
            v2u* o8 = (v2u*)(xn + (size_t)m * D) + lane;
#pragma unroll
            for (int j = 0; j < 8; ++j) { const f32x4 w = ((const f32x4*)w_next)[lane + 64 * j]; v2u o; o.x = pk2(x[j].x * r2 * w.x, x[j].y * r2 * w.y); o.y = pk2(x[j].z * r2 * w.z, x[j].w * r2 * w.w); o8[64 * j] = o; }
        }
    }
}

__device__ __forceinline__ void unpack8(const v4u a, float (&f)[8]) { f[0] = bflo(a.x); f[1] = bfhi(a.x); f[2] = bflo(a.y); f[3] = bfhi(a.y); f[4] = bflo(a.z); f[5] = bfhi(a.z); f[6] = bflo(a.w); f[7] = bfhi(a.w); }
__device__ __forceinline__ v4u pack8(const float (&f)[8]) { v4u o; o.x = pk2(f[0], f[1]); o.y = pk2(f[2], f[3]); o.z = pk2(f[4], f[5]); o.w = pk2(f[6], f[7]); return o; }

typedef pg8::bf16x8 bfx8;
#define MFMA16(a, b, c) __builtin_amdgcn_mfma_f32_16x16x32_bf16(a, b, c, 0, 0, 0)
constexpr int QS = 136, TS = 72;
constexpr int OSS = 132;
constexpr int L_QD = 0, L_QH = 64 * QS * 2, L_KH = 2 * 64 * QS * 2, L_VT = 3 * 64 * QS * 2, L_AM = L_VT + 128 * TS * 2, L_OS = L_AM + 64 * TS * 2, L_TOT = L_OS + 64 * OSS * 4, L_RECEND = L_TOT + 2048;
static_assert(L_RECEND <= 131072, "LDS map of the recurrence passes");
constexpr size_t REC_UT = 0, REC_ST = 256 * MiB, REC_DEC = 384 * MiB;

__device__ __forceinline__ void chunk_cumsum(const float* LFbase, int t0, int dir, int k, int ig, LAS float* TOT, float (&lf)[16], float (&bb)[16], float& blast, float& r31) {
#pragma unroll
    for (int j = 0; j < 16; ++j) { const int i = 16 * ig + j; const int t = dir ? (t0 + 63 - i) : (t0 + i); lf[j] = LFbase[(size_t)t * D + k]; }
    float run = 0.f;
#pragma unroll
    for (int j = 0; j < 16; ++j) { run += lf[j]; bb[j] = run; }
    TOT[ig * 128 + k] = run;
    __syncthreads();
    const float s0 = TOT[k], s1 = TOT[128 + k], s2 = TOT[256 + k], s3 = TOT[384 + k];
    const float base = (ig > 0 ? s0 : 0.f) + (ig > 1 ? s1 : 0.f) + (ig > 2 ? s2 : 0.f);
#pragma unroll
    for (int j = 0; j < 16; ++j) bb[j] += base;
    blast = (s0 + s1) + (s2 + s3); r31 = s0 + s1;
}
__device__ __forceinline__ void load_colT(const bf16* base, int t0, int dir, int col, int ig, LAS bf16* T) {
    unsigned w[8];
#pragma unroll
    for (int j = 0; j < 8; ++j) { const int i = 16 * ig + 2 * j; const int ta = dir ? (t0 + 63 - i) : (t0 + i), tb = dir ? (ta - 1) : (ta + 1);
        w[j] = (unsigned)base[(size_t)ta * D + col] | ((unsigned)base[(size_t)tb * D + col] << 16); }
    LAS v4u* o = (LAS v4u*)(T + col * TS + 16 * ig);
    v4u o0, o1; o0.x = w[0]; o0.y = w[1]; o0.z = w[2]; o0.w = w[3]; o1.x = w[4]; o1.y = w[5]; o1.z = w[6]; o1.w = w[7];
    o[0] = o0; o[1] = o1;
}

__device__ __forceinline__ void rec_pass1(LAS unsigned char* lds, const bf16* V, const float* LFf, const float* LFb, float* UT, float* DEC, int tid) {
    const int lane = tid & 63, wave = __builtin_amdgcn_readfirstlane(tid >> 6), k = tid & 127, ig = tid >> 7, fr = lane & 15, fq = lane >> 4;
    LAS bf16* KT = (LAS bf16*)(lds + L_QD); LAS bf16* VT = (LAS bf16*)(lds + L_VT); LAS float* TOT = (LAS float*)(lds + L_TOT);
    for (int task = blockIdx.x; task < 4096; task += gridDim.x) {
        const int c = task & 63, seq = task >> 6, h = seq & 15, b = (seq >> 4) & 1, dir = seq >> 5;
        const int t0 = 64 * (dir ? 63 - c : c);
        const float* LFbase = (dir ? LFb : LFf) + (size_t)b * SEQ * D + h * HK;
        float lf[16], bb[16], blast, r31;
        chunk_cumsum(LFbase, t0, dir, k, ig, TOT, lf, bb, blast, r31);
        unsigned w[8];
#pragma unroll
        for (int j = 0; j < 8; ++j) { const float k0 = (1.0f - __expf(lf[2 * j])) * __expf(blast - bb[2 * j]), k1 = (1.0f - __expf(lf[2 * j + 1])) * __expf(blast - bb[2 * j + 1]); w[j] = pk2(k0, k1); }
        { LAS v4u* o = (LAS v4u*)(KT + k * TS + 16 * ig); v4u o0, o1; o0.x = w[0]; o0.y = w[1]; o0.z = w[2]; o0.w = w[3]; o1.x = w[4]; o1.y = w[5]; o1.z = w[6]; o1.w = w[7]; o[0] = o0; o[1] = o1; }
        load_colT(V + (size_t)b * SEQ * D + h * HK, t0, dir, k, ig, VT);
        if (ig == 0) DEC[(size_t)task * 128 + k] = __expf(blast);
        __syncthreads();
        f32x4 acc[8];
#pragma unroll
        for (int n = 0; n < 8; ++n) acc[n] = (f32x4){0.f, 0.f, 0.f, 0.f};
#pragma unroll
        for (int ks = 0; ks < 2; ++ks) {
            const bfx8 a = *(const LAS bfx8*)(VT + (16 * wave + fr) * TS + 32 * ks + 8 * fq);
#pragma unroll
            for (int n = 0; n < 8; ++n) { const bfx8 bt = *(const LAS bfx8*)(KT + (16 * n + fr) * TS + 32 * ks + 8 * fq); acc[n] = MFMA16(bt, a, acc[n]); }
        }
        float* o = UT + (size_t)task * 16384 + (16 * wave + fr) * 128 + 4 * fq;
#pragma unroll
        for (int n = 0; n < 8; ++n) *(f32x4*)(o + 16 * n) = acc[n];
        __syncthreads();
    }
}
__device__ __forceinline__ void rec_pass2(const float* UT, const float* DEC, bf16* ST, int gtid, int NT) {
    for (int item = gtid; item < 64 * 4096; item += NT) {
        const int seq = item >> 12, e4 = (item & 4095) * 4, k4 = e4 & 127;
        const float* up = UT + (size_t)seq * 64 * 16384 + e4; const float* dp = DEC + (size_t)seq * 64 * 128 + k4; bf16* sp = ST + (size_t)seq * 64 * 16384 + e4;
        f32x4 s = (f32x4){0.f, 0.f, 0.f, 0.f};
#pragma unroll 8
        for (int c = 0; c < 64; ++c) {
            const f32x4 u = *(const f32x4*)(up + (size_t)c * 16384); const f32x4 d = *(const f32x4*)(dp + c * 128);
            v2u o; o.x = pk2(s.x, s.y); o.y = pk2(s.z, s.w); *(v2u*)(sp + (size_t)c * 16384) = o;
            s = d * s + u;
        }
    }
}
__device__ __forceinline__ void rec_pass3(LAS unsigned char* lds, const bf16* Q, const bf16* V, const bf16* Gt, const float* LFf, const float* LFb, const bf16* ST, const float* gnw, bf16* Yo, int tid) {
    const int lane = tid & 63, wave = __builtin_amdgcn_readfirstlane(tid >> 6), k = tid & 127, ig = tid >> 7, fr = lane & 15, fq = lane >> 4;
    LAS bf16* QDl = (LAS bf16*)(lds + L_QD); LAS bf16* QHl = (LAS bf16*)(lds + L_QH); LAS bf16* KHl = (LAS bf16*)(lds + L_KH); LAS bf16* VT = (LAS bf16*)(lds + L_VT);
    LAS bf16* AM = (LAS bf16*)(lds + L_AM); LAS float* OS = (LAS float*)(lds + L_OS); LAS float* TOT = (LAS float*)(lds + L_TOT);
    for (int task = blockIdx.x; task < 2048; task += gridDim.x) {
        const int C = task & 63, h = (task >> 6) & 15, b = task >> 10, t0 = 64 * C;
#pragma unroll 1
        for (int dir = 0; dir < 2; ++dir) {
            const int c = dir ? 63 - C : C, seq = (dir * 2 + b) * 16 + h;
            const float* LFbase = (dir ? LFb : LFf) + (size_t)b * SEQ * D + h * HK;
            float lf[16], bb[16], blast, r31;
            chunk_cumsum(LFbase, t0, dir, k, ig, TOT, lf, bb, blast, r31);
            const bf16* Qbase = Q + (size_t)b * SEQ * D + h * HK + k;
#pragma unroll
            for (int j = 0; j < 16; ++j) { const int i = 16 * ig + j; const int t = dir ? (t0 + 63 - i) : (t0 + i);
                const float qv = bf2f(Qbase[(size_t)t * D]);
                const float eb = __expf(bb[j]), e1 = __expf(bb[j] - r31), e2 = __expf(r31 - bb[j]), kk = 1.0f - __expf(lf[j]);
                QDl[i * QS + k] = (bf16)f2bf(qv * eb); QHl[i * QS + k] = (bf16)f2bf(qv * e1); KHl[i * QS + k] = (bf16)f2bf(kk * e2); }
            load_colT(V + (size_t)b * SEQ * D + h * HK, t0, dir, k, ig, VT);
            __syncthreads();
            {
                const int it = wave >> 1;
#pragma unroll
                for (int jj = 0; jj < 2; ++jj) { const int jt = 2 * (wave & 1) + jj;
                    f32x4 a4 = (f32x4){0.f, 0.f, 0.f, 0.f};
                    if (jt <= it) {
#pragma unroll
                        for (int ks = 0; ks < 4; ++ks) { const bfx8 a = *(const LAS bfx8*)(QHl + (16 * it + fr) * QS + 32 * ks + 8 * fq); const bfx8 bt = *(const LAS bfx8*)(KHl + (16 * jt + fr) * QS + 32 * ks + 8 * fq); a4 = MFMA16(bt, a, a4); }
                    }
                    const int ii = 16 * it + fr, j0 = 16 * jt + 4 * fq;
                    const float m0 = (jt <= it && j0 + 0 <= ii) ? a4.x : 0.f, m1 = (jt <= it && j0 + 1 <= ii) ? a4.y : 0.f, m2 = (jt <= it && j0 + 2 <= ii) ? a4.z : 0.f, m3 = (jt <= it && j0 + 3 <= ii) ? a4.w : 0.f;
                    v2u o; o.x = pk2(m0, m1); o.y = pk2(m2, m3); *(LAS v2u*)(AM + ii * TS + j0) = o; }
            }
            __syncthreads();
            {
                const int it = wave & 3, vh = wave >> 2;
                f32x4 o4[4];
#pragma unroll
                for (int n = 0; n < 4; ++n) o4[n] = (f32x4){0.f, 0.f, 0.f, 0.f};
                const bf16* STt = ST + ((size_t)seq * 64 + c) * 16384;
#pragma unroll
                for (int ks = 0; ks < 4; ++ks) { const bfx8 a = *(const LAS bfx8*)(QDl + (16 * it + fr) * QS + 32 * ks + 8 * fq);
#pragma unroll
                    for (int n = 0; n < 4; ++n) { const bfx8 bt = *(const bfx8*)(STt + (64 * vh + 16 * n + fr) * 128 + 32 * ks + 8 * fq); o4[n] = MFMA16(bt, a, o4[n]); } }
#pragma unroll
                for (int ks = 0; ks < 2; ++ks) { const bfx8 a = *(const LAS bfx8*)(AM + (16 * it + fr) * TS + 32 * ks + 8 * fq);
#pragma unroll
                    for (int n = 0; n < 4; ++n) { const bfx8 bt = *(const LAS bfx8*)(VT + (64 * vh + 16 * n + fr) * TS + 32 * ks + 8 * fq); o4[n] = MFMA16(bt, a, o4[n]); } }
                const int i = 16 * it + fr, tl = dir ? 63 - i : i;
#pragma unroll
                for (int n = 0; n < 4; ++n) { LAS f32x4* p = (LAS f32x4*)(OS + tl * OSS + 64 * vh + 16 * n + 4 * fq); if (dir == 0) *p = o4[n]; else *p = *p + o4[n]; }
            }
            __syncthreads();
        }
        {
            const int row = tid >> 3, vseg = tid & 7;
            const LAS f32x4* p = (const LAS f32x4*)(OS + row * OSS + 16 * vseg);
            f32x4 o[4]; float ss = 0.f;
#pragma unroll
            for (int x4 = 0; x4 < 4; ++x4) { o[x4] = p[x4]; ss += (o[x4].x * o[x4].x + o[x4].y * o[x4].y) + (o[x4].z * o[x4].z + o[x4].w * o[x4].w); }
            ss += __shfl_xor(ss, 1); ss += __shfl_xor(ss, 2); ss += __shfl_xor(ss, 4);
            const float r = __builtin_amdgcn_rsqf(ss * (1.f / HK) + EPS);
            const size_t goff = (size_t)(b * SEQ + t0 + row) * D + h * HK + 16 * vseg;
            float g[8], y[8];
#pragma unroll
            for (int hh = 0; hh < 2; ++hh) { unpack8(*(const v4u*)(Gt + goff + 8 * hh), g);
                const f32x4 w0 = *(const f32x4*)(gnw + 16 * vseg + 8 * hh), w1 = *(const f32x4*)(gnw + 16 * vseg + 8 * hh + 4);
                const f32x4 oa = o[2 * hh], ob = o[2 * hh + 1];
                y[0] = oa.x * r * w0.x * g[0]; y[1] = oa.y * r * w0.y * g[1]; y[2] = oa.z * r * w0.z * g[2]; y[3] = oa.w * r * w0.w * g[3];
                y[4] = ob.x * r * w1.x * g[4]; y[5] = ob.y * r * w1.y * g[5]; y[6] = ob.z * r * w1.z * g[6]; y[7] = ob.w * r * w1.w * g[7];
                *(v4u*)(Yo + goff + 8 * hh) = pack8(y); }
        }
    }
}

__device__ __forceinline__ void sconv_phase(const bf16* U, const float* wc, bf16* Y, int gtid, int NT) {
    for (int idx = gtid; idx < M * (D / 8); idx += NT) {
        const int m = idx >> 8, c0 = (idx & 255) * 8, tp = m & (SEQ - 1);
        float w0[8], w1[8], w2[8];
#pragma unroll
        for (int e = 0; e < 8; ++e) { w0[e] = wc[c0 + e]; w1[e] = wc[D + c0 + e]; w2[e] = wc[2 * D + c0 + e]; }
        const bf16* r = U + (size_t)m * N_SC + c0;
        float gb[8], c[8], x[8], z[8];
        unpack8(*(const v4u*)(r), gb); unpack8(*(const v4u*)(r + D), c); unpack8(*(const v4u*)(r + 2 * D), x);
#pragma unroll
        for (int e = 0; e < 8; ++e) z[e] = w1[e] * (c[e] * x[e]);
        if (tp > 0) { unpack8(*(const v4u*)(r - N_SC + D), c); unpack8(*(const v4u*)(r - N_SC + 2 * D), x);
#pragma unroll
            for (int e = 0; e < 8; ++e) z[e] += w0[e] * (c[e] * x[e]); }
        if (tp < SEQ - 1) { unpack8(*(const v4u*)(r + N_SC + D), c); unpack8(*(const v4u*)(r + N_SC + 2 * D), x);
#pragma unroll
            for (int e = 0; e < 8; ++e) z[e] += w2[e] * (c[e] * x[e]); }
#pragma unroll
        for (int e = 0; e < 8; ++e) z[e] *= gb[e];
        *(v4u*)(Y + (size_t)m * D + c0) = pack8(z);
    }
}

__device__ __forceinline__ void ffnact_phase(const bf16* UP, const float* wc, bf16* ACT, int gtid, int NT) {
    constexpr int CB = FF / 8;
    for (int idx = gtid; idx < M * CB; idx += NT) {
        const int m = idx / CB, c0 = (idx - m * CB) * 8, tp = m & (SEQ - 1);
        const bf16* r = UP + (size_t)m * N_FI + c0;
        float g[8], v[8], a[8], b[8];
        unpack8(*(const v4u*)(r), a); unpack8(*(const v4u*)(r + FF), b);
#pragma unroll
        for (int e = 0; e < 8; ++e) { g[e] = wc[N_FI + c0 + e] * a[e]; v[e] = wc[N_FI + FF + c0 + e] * b[e]; }
        if (tp > 0) { unpack8(*(const v4u*)(r - N_FI), a); unpack8(*(const v4u*)(r - N_FI + FF), b);
#pragma unroll
            for (int e = 0; e < 8; ++e) { g[e] += wc[c0 + e] * a[e]; v[e] += wc[FF + c0 + e] * b[e]; } }
        if (tp < SEQ - 1) { unpack8(*(const v4u*)(r + N_FI), a); unpack8(*(const v4u*)(r + N_FI + FF), b);
#pragma unroll
            for (int e = 0; e < 8; ++e) { g[e] += wc[2 * N_FI + c0 + e] * a[e]; v[e] += wc[2 * N_FI + FF + c0 + e] * b[e]; } }
#pragma unroll
        for (int e = 0; e < 8; ++e) g[e] = g[e] * fsig(g[e]) * v[e];
        *(v4u*)(ACT + (size_t)m * FF + c0) = pack8(g);
    }
}

#define XB_TMO      128
#define XB_XCNT(j)  (256  + 64 * (j))
#define XB_XSUB(j)  (1280 + 64 * (j))
#define XB_XGEN(j)  (2304 + 64 * (j))
#define XB_TOP      3328
#define XB_TOPGEN   3392
#define XCD_BAR_WORDS 3456
#define XB_SPIN_CAP (1u << 18)

__device__ __forceinline__ unsigned xb_ld(unsigned* p)              { return __hip_atomic_load(p, __ATOMIC_RELAXED, __HIP_MEMORY_SCOPE_AGENT); }
__device__ __forceinline__ unsigned xb_add(unsigned* p, unsigned v) { return __hip_atomic_fetch_add(p, v, __ATOMIC_RELAXED, __HIP_MEMORY_SCOPE_AGENT); }
__device__ __forceinline__ unsigned xb_xcc_id() { return (unsigned)__builtin_amdgcn_s_getreg((3 << 11) | 20) & 0xFu; }
#define XB_SPIN(cond, bar) do { unsigned _sp = 0; while (cond) { __builtin_amdgcn_s_sleep(1); \
    if ((++_sp & 255u) == 0u) { if (xb_ld(&(bar)[XB_TMO])) break; if (_sp > XB_SPIN_CAP) { atomicAdd(&(bar)[XB_TMO], 1u); break; } } } } while (0)

struct XcdBarrier {
    unsigned* bar; unsigned x;
    volatile LAS unsigned* st;
};

__device__ __forceinline__ XcdBarrier xcd_barrier_post(unsigned* bar, volatile LAS unsigned* st) {
    XcdBarrier b; b.bar = bar; b.x = xb_xcc_id(); b.st = st;
    if (threadIdx.x == 0) (void)xb_add(&bar[XB_XCNT(b.x)], 1u);
    return b;
}
__device__ __forceinline__ void xcd_barrier_complete(unsigned* bar, unsigned x, unsigned& nloc, unsigned& nx) {
    const unsigned G = gridDim.x * gridDim.y * gridDim.z;
    unsigned sum, cnt, mine, sp = 0u;
    for (;;) {
        sum = 0u; cnt = 0u; mine = 0u;
#pragma unroll
        for (unsigned j = 0; j < 16; ++j) { const unsigned c = xb_ld(&bar[XB_XCNT(j)]); sum += c; cnt += (c > 0u) ? 1u : 0u; mine = (j == x) ? c : mine; }
        if (sum == G) break;
        __builtin_amdgcn_s_sleep(1);
        if ((++sp & 255u) == 0u) { if (xb_ld(&bar[XB_TMO])) break; if (sp > XB_SPIN_CAP) { atomicAdd(&bar[XB_TMO], 1u); break; } }
    }
    nloc = mine > 0u ? mine : 1u; nx = cnt > 0u ? cnt : 1u;
}

__device__ __forceinline__ void xcd_barrier(const XcdBarrier& b) {
    asm volatile("s_waitcnt vmcnt(0)" ::: "memory");
    __syncthreads();
    if (threadIdx.x == 0) {
        unsigned* bar = b.bar;
        __builtin_amdgcn_s_waitcnt(0);
        unsigned nloc = b.st[0], nx = b.st[1];
        if (nloc == 0u) { xcd_barrier_complete(bar, b.x, nloc, nx); b.st[0] = nloc; b.st[1] = nx; }
        const unsigned old = xb_add(&bar[XB_XSUB(b.x)], 1u);
        const unsigned gen = old / nloc;
        if (old + 1u == (gen + 1u) * nloc) {
            __builtin_amdgcn_fence(__ATOMIC_RELEASE, "agent");
            asm volatile("s_waitcnt vmcnt(0)" ::: "memory");
            const unsigned og = xb_add(&bar[XB_TOP], 1u);
            const unsigned tg = og / nx;
            if (og + 1u == (tg + 1u) * nx) xb_add(&bar[XB_TOPGEN], 1u);
            else XB_SPIN(xb_ld(&bar[XB_TOPGEN]) == tg, bar);
            __builtin_amdgcn_fence(__ATOMIC_ACQUIRE, "agent");
            xb_add(&bar[XB_XGEN(b.x)], 1u);
            asm volatile("s_waitcnt vmcnt(0)" ::: "memory");
        } else {
            XB_SPIN(xb_ld(&bar[XB_XGEN(b.x)]) == gen, bar);
            __builtin_amdgcn_fence(__ATOMIC_ACQUIRE, "agent");
            asm volatile("s_waitcnt vmcnt(0)" ::: "memory");
        }
    }
    __syncthreads();
}

struct Args { const float* in[15]; float* out; unsigned char* ws; int ph_lo, ph_hi; };
constexpr int N_PHASES = 1 + 2 * 10 + 2 * 8;

template <class Epi>
__device__ __forceinline__ void run_gemm(LAS unsigned char* lds, const bf16* A, const bf16* Bt, int N, int K, const Epi& E) {
    pg8::Gemm g{A, Bt, M, N, K}; pg8::StaticOrder S; S.init(M, N, (int)gridDim.x, (int)blockIdx.x);
    pg8::gemm_phase<Epi, pg8::StaticOrder, true, true>(lds, g, S, E);
}

__global__ void __launch_bounds__(NTHR, 2) mega_fwd(Args args) {
    extern __shared__ __attribute__((aligned(16))) unsigned char lds_raw[];
    LAS unsigned char* lds = (LAS unsigned char*)lds_raw;
    cg::grid_group grid = cg::this_grid();
    volatile LAS unsigned* bst = (volatile LAS unsigned*)(lds + LDS_BYTES - 64);
    if (threadIdx.x < 16) bst[threadIdx.x] = 0u;
    __syncthreads();
    XcdBarrier xbar = xcd_barrier_post((unsigned*)(args.ws + WS_CTL) + 4096, bst);
    const int lo = args.ph_lo, hi = args.ph_hi;
    int ph = 0;
#define PH_BEGIN if (ph >= lo && ph < hi) { \
    int tid = threadIdx.x; asm volatile("" : "+v"(tid)); \
    const int lane = tid & 63, wave = __builtin_amdgcn_readfirstlane(tid >> 6); \
    const int G = gridDim.x, gw = blockIdx.x * NWAVES + wave, NGW = G * NWAVES, gtid = blockIdx.x * NTHR + tid, NT = G * NTHR; \
    unsigned char* ws = args.ws; asm volatile("" : "+s"(ws)); \
    (void)lane; (void)gw; (void)NGW; (void)gtid; (void)NT;
#define PH_END } ++ph; if (ph - 1 >= lo && ph < hi) { if (ph == 1) grid.sync(); else xcd_barrier(xbar); }
#define x_in args.in[0]
#define hg_w_in args.in[1]
#define hg_w_out args.in[2]
#define hg_gn args.in[3]
#define hg_lb args.in[4]
#define sc_w_in args.in[5]
#define sc_w_conv args.in[6]
#define sc_w_out args.in[7]
#define ff_w_in args.in[8]
#define ff_w_conv args.in[9]
#define ff_w_out args.in[10]
#define n_pre_mix args.in[11]
#define n_post_mix args.in[12]
#define n_pre_ffn args.in[13]
#define n_post_ffn args.in[14]
#define WHGI ((bf16*)(ws + WS_WHGI))
#define WHGO ((bf16*)(ws + WS_WHGO))
#define WSCI ((bf16*)(ws + WS_WSCI))
#define WSCO ((bf16*)(ws + WS_WSCO))
#define WFI ((bf16*)(ws + WS_WFI))
#define WFO ((bf16*)(ws + WS_WFO))
#define X ((float*)(ws + WS_X))
#define XN ((bf16*)(ws + WS_XN))
#define MB ((float*)(ws + WS_MBUF))
#define U (ws + WS_U)
#define ACT ((bf16*)(ws + WS_ACT))
#define Y ((bf16*)(ws + WS_ACT))
#define Qb ((bf16*)(ws + WS_U + U_Q))
#define Vb ((bf16*)(ws + WS_U + U_V))
#define Gb ((bf16*)(ws + WS_U + U_G))
#define LFf ((float*)(ws + WS_U + U_LFF))
#define LFb ((float*)(ws + WS_U + U_LFB))
#define Of ((float*)(ws + WS_REC))
#define Ob ((float*)(ws + WS_REC + 64 * MiB))

    PH_BEGIN
        LAS float* scr = (LAS float*)(lds + wave * 16384);
        for (int j = 0; j < 2; ++j) {
            transpose_matrix(hg_w_in + (size_t)j * D * N_HG, D, N_HG, WHGI + (size_t)j * N_HG * D, scr, gw, NGW, lane);
            transpose_matrix(hg_w_out + (size_t)j * D * D, D, D, WHGO + (size_t)j * D * D, scr, gw, NGW, lane);
            transpose_matrix(sc_w_in + (size_t)j * D * N_SC, D, N_SC, WSCI + (size_t)j * N_SC * D, scr, gw, NGW, lane);
            transpose_matrix(sc_w_out + (size_t)j * D * D, D, D, WSCO + (size_t)j * D * D, scr, gw, NGW, lane);
        }
        for (int i = 0; i < DEPTH; ++i) {
            transpose_matrix(ff_w_in + (size_t)i * D * N_FI, D, N_FI, WFI + (size_t)i * N_FI * D, scr, gw, NGW, lane);
            transpose_matrix(ff_w_out + (size_t)i * FF * D, FF, D, WFO + (size_t)i * D * FF, scr, gw, NGW, lane);
        }
        rownorm_phase(x_in, nullptr, nullptr, n_pre_mix, X, XN, gw, NGW, lane);
    PH_END

    for (int i = 0; i < DEPTH; ++i) {
        const int j = i >> 1;
        if ((i & 1) == 0) {
            PH_BEGIN
                pg8::EpiHgrn E{U, hg_lb, j};
                run_gemm(lds, XN, WHGI + (size_t)j * N_HG * D, N_HG, D, E);
            PH_END
            PH_BEGIN
                rec_pass1(lds, Vb, LFf, LFb, (float*)(ws + WS_REC + REC_UT), (float*)(ws + WS_REC + REC_DEC), tid);
            PH_END
            PH_BEGIN
                rec_pass2((const float*)(ws + WS_REC + REC_UT), (const float*)(ws + WS_REC + REC_DEC), (bf16*)(ws + WS_REC + REC_ST), gtid, NT);
            PH_END
            PH_BEGIN
                rec_pass3(lds, Qb, Vb, Gb, LFf, LFb, (const bf16*)(ws + WS_REC + REC_ST), hg_gn + (size_t)j * HK, Y, tid);
            PH_END
            PH_BEGIN
                pg8::EpiF32 E{MB, D};
                run_gemm(lds, Y, WHGO + (size_t)j * D * D, D, D, E);
            PH_END
        } else {
            PH_BEGIN
                pg8::EpiBf16 E{(bf16*)U, N_SC};
                run_gemm(lds, XN, WSCI + (size_t)j * N_SC * D, N_SC, D, E);
            PH_END
            PH_BEGIN
                sconv_phase((const bf16*)U, sc_w_conv + (size_t)j * 3 * D, Y, gtid, NT);
            PH_END
            PH_BEGIN
                pg8::EpiF32 E{MB, D};
                run_gemm(lds, Y, WSCO + (size_t)j * D * D, D, D, E);
            PH_END
        }
        PH_BEGIN
            rownorm_phase(X, MB, n_post_mix + (size_t)i * D, n_pre_ffn + (size_t)i * D, X, XN, gw, NGW, lane);
        PH_END
        PH_BEGIN
            pg8::EpiBf16 E{(bf16*)U, N_FI};
            run_gemm(lds, XN, WFI + (size_t)i * N_FI * D, N_FI, D, E);
        PH_END
        PH_BEGIN
            ffnact_phase((const bf16*)U, ff_w_conv + (size_t)i * 3 * N_FI, ACT, gtid, NT);
        PH_END
        PH_BEGIN
            pg8::EpiF32 E{MB, D};
            run_gemm(lds, ACT, WFO + (size_t)i * D * FF, D, FF, E);
        PH_END
        PH_BEGIN
            if (i == DEPTH - 1) rownorm_phase(X, MB, n_post_ffn + (size_t)i * D, nullptr, args.out, nullptr, gw, NGW, lane);
            else rownorm_phase(X, MB, n_post_ffn + (size_t)i * D, n_pre_mix + (size_t)(i + 1) * D, X, XN, gw, NGW, lane);
        PH_END
    }
#undef PH_BEGIN
#undef PH_END
#undef X
#undef Y
#undef U
}

#ifndef MK_MULTI
#define MK_MULTI 0
#endif
extern "C" void kernel_launch(void* const* d_in, const int* in_sizes, int n_in, void* d_out, int out_size, void* d_ws, size_t ws_size, hipStream_t stream) {
    static int grid = 0;
    if (grid == 0) {
        if (n_in != 15 || out_size != M * D || ws_size < WS_END) { fprintf(stderr, "kernel_launch: unexpected shapes (n_in %d out %d ws %zu)\n", n_in, out_size, ws_size); grid = -1; return; }
        int dev = 0, cus = 0, per_cu = 0;
        hipGetDevice(&dev); hipDeviceGetAttribute(&cus, hipDeviceAttributeMultiprocessorCount, dev);
        if (hipFuncSetAttribute((const void*)mega_fwd, hipFuncAttributeMaxDynamicSharedMemorySize, LDS_BYTES) != hipSuccess) { fprintf(stderr, "hipFuncSetAttribute failed\n"); grid = -1; return; }
        if (hipOccupancyMaxActiveBlocksPerMultiprocessor(&per_cu, (const void*)mega_fwd, NTHR, LDS_BYTES) != hipSuccess || per_cu < 1) { fprintf(stderr, "occupancy query: %d\n", per_cu); per_cu = 1; }
        (void)hipGetLastError();
        grid = cus * 1;
    }
    if (grid < 0) return;
    if (hipMemsetAsync((char*)d_ws + WS_CTL, 0, 65536, stream) != hipSuccess) { fprintf(stderr, "memset failed\n"); return; }
    Args a{};
    for (int i = 0; i < 15; ++i) a.in[i] = (const float*)d_in[i];
    a.out = (float*)d_out; a.ws = (unsigned char*)d_ws;
#if MK_MULTI
    for (int p = 0; p < N_PHASES; ++p) { a.ph_lo = p; a.ph_hi = p + 1; hipLaunchKernelGGL(mega_fwd, dim3(grid), dim3(NTHR), LDS_BYTES, stream, a); }
#else
    a.ph_lo = 0; a.ph_hi = N_PHASES;
    void* kargs[] = {&a};
    hipError_t e = hipLaunchCooperativeKernel((const void*)mega_fwd, dim3(grid), dim3(NTHR), kargs, LDS_BYTES, stream);
    if (e != hipSuccess) fprintf(stderr, "cooperative launch failed: %s (grid %d)\n", hipGetErrorString(e), grid);
#endif
}
```

```cpp
#include <hip/hip_runtime.h>
#include <hip/hip_cooperative_groups.h>
#include <cstdio>
#include <cstdint>
namespace cg = cooperative_groups;
namespace pg8 {
#define PG8_LAS __attribute__((address_space(3)))
typedef unsigned short bf16_t;
typedef short bf16x8 __attribute__((ext_vector_type(8)));
typedef float f32x4 __attribute__((ext_vector_type(4)));
typedef unsigned u32x4 __attribute__((ext_vector_type(4)));
constexpr int BM = 256, BK = 64, HALF = 128, HTB = HALF * BK * 2  , STAGE_BYTES = 8 * HTB, NXCD = 8, WGM = 8;

__host__ __device__ __forceinline__ int lds_byte(int r, int c) { const int st = (r >> 4) * 2 + (c >> 5), rr = r & 15, cc = c & 31, ob = rr * 64 + cc * 2; return st * 1024 + (ob ^ (((ob >> 9) & 1) << 5)); }
__host__ __device__ __forceinline__ void stage_rc(int b, int& R, int& C) { const int st = b / 1024, sb = b % 1024, swz = sb ^ (((sb >> 9) & 1) << 5); R = (st >> 1) * 16 + swz / 64; C = (st & 1) * 32 + (swz % 64) / 2; }
__host__ __device__ __forceinline__ int perm32(int rho) { const int n = rho >> 4, i = rho & 15; return 8 * (i >> 2) + 4 * n + (i & 3); }

struct Unit { int pm, pn; };
struct Gemm { const bf16_t* A; const bf16_t* Bt; int M, N, K; };

struct StaticOrder {
    int nM, nN, nwg, G, c;
    __host__ __device__ void init(int M, int N, int G_, int c_) { nM = M / BM; nN = N / BM; nwg = nM * nN; G = G_; c = c_; }
    __host__ __device__ bool next(int i, Unit& u) const {
        const long L = (long)i * G + c; if (L >= nwg) return false;
        int wgid = (int)L; { const int q = nwg / NXCD, r = nwg % NXCD, xcd = wgid % NXCD, off = wgid / NXCD; wgid = (xcd < r ? xcd * (q + 1) : r * (q + 1) + (xcd - r) * q) + off; }
        const int nig = WGM * nN, gid = wgid / nig, fm = gid * WGM, gsz = (nM - fm) < WGM ? (nM - fm) : WGM;
        u.pm = fm + ((wgid % nig) % gsz); u.pn = (wgid % nig) / gsz; return true;
    }
    __device__ __forceinline__ void a_ready(const Unit&) const {}
    __device__ __forceinline__ void done(const Unit&) const {}
};
__device__ __forceinline__ unsigned cvt_pk_bf16(float lo, float hi) { unsigned r; asm volatile("v_cvt_pk_bf16_f32 %0, %1, %2" : "=v"(r) : "v"(lo), "v"(hi)); return r; }
typedef float f32x2 __attribute__((ext_vector_type(2)));
template <class Epi, class Sched, bool ALIGN_EPI = false, bool SP2 = false>
__device__ __forceinline__ void gemm_phase(PG8_LAS unsigned char* lds, const Gemm g, const Sched& S, const Epi& E) {
    int tid_o = threadIdx.x; asm volatile("" : "+v"(tid_o));
    const int tid = tid_o, wid = __builtin_amdgcn_readfirstlane(tid >> 6), lane = tid & 63, wr = wid >> 2, wc = wid & 3, fr = lane & 15, fq = lane >> 4;
    const int K = g.K, nt = K / BK;
    unsigned voffA[2], voffB[2];
#pragma unroll
    for (int i = 0; i < 2; ++i) { int R, C; stage_rc(tid * 16 + i * 8192, R, C); const int Rb = Epi::PERM ? ((R & ~31) + perm32(R & 31)) : R;
        voffA[i] = (unsigned)(R * K + C) * 2u; voffB[i] = (unsigned)(Rb * K + C) * 2u; }
    const size_t kstep = (size_t)(BK * 2);
    const size_t hstep = (size_t)HALF * K * 2;
    const size_t tstep = 2 * hstep;
    const unsigned ldsw = (unsigned)wid * 1024u;
    const int aoff = lds_byte(wr * 64 + fr, fq * 8), boff = lds_byte(wc * 32 + fr, fq * 8);
#define PG8_SA(b, h) (((b) * 2 + (h)) * HTB)
#define PG8_SB(b, h) ((4 + (b) * 2 + (h)) * HTB)
#define PG8_STAGE(bufoff, gbase, voff) do { _Pragma("unroll") for (int _i = 0; _i < 2; ++_i) \
        __builtin_amdgcn_global_load_lds((const unsigned*)((const char*)(gbase) + (voff)[_i]), (PG8_LAS unsigned*)(lds + (bufoff) + ldsw + _i * 8192), 16, 0, 0); } while (0)
#define PG8_LDA(dst, b, h) do { _Pragma("unroll") for (int m = 0; m < 4; ++m) _Pragma("unroll") for (int k = 0; k < 2; ++k) dst[m][k] = *(const PG8_LAS bf16x8*)(lds + PG8_SA(b, h) + aoff + m * 2048 + k * 1024); } while (0)
#define PG8_LDB(dst, b, h) do { _Pragma("unroll") for (int n = 0; n < 2; ++n) _Pragma("unroll") for (int k = 0; k < 2; ++k) dst[n][k] = *(const PG8_LAS bf16x8*)(lds + PG8_SB(b, h) + boff + n * 2048 + k * 1024); } while (0)
#define PG8_MMA(ai, bj, At, Bt) do { __builtin_amdgcn_s_setprio(1); _Pragma("unroll") for (int m = 0; m < 4; ++m) _Pragma("unroll") for (int n = 0; n < 2; ++n) _Pragma("unroll") for (int k = 0; k < 2; ++k) \
        acc[ai][bj][m][n] = __builtin_amdgcn_mfma_f32_16x16x32_bf16(Bt[n][k], At[m][k], acc[ai][bj][m][n], 0, 0, 0); __builtin_amdgcn_s_setprio(0); } while (0)
#define PG8_WAIT_V(n) asm volatile("s_waitcnt vmcnt(" #n ")" ::: "memory")
#define PG8_WAIT_L(n) asm volatile("s_waitcnt lgkmcnt(" #n ")" ::: "memory")
#define PG8_BAR __builtin_amdgcn_s_barrier()
#define PG8_SCHED __builtin_amdgcn_sched_barrier(0)
    Unit cur, nxt; int ui = 0;
    if (!S.next(0, cur)) return;
    f32x4 acc[2][2][4][2];
#pragma unroll
    for (int a = 0; a < 2; ++a)
#pragma unroll
        for (int b = 0; b < 2; ++b)
#pragma unroll
            for (int m = 0; m < 4; ++m)
#pragma unroll
                for (int n = 0; n < 2; ++n) acc[a][b][m][n] = (f32x4){0.f, 0.f, 0.f, 0.f};
    bf16x8 At[4][2], B0[2][2], B1[2][2];
    const char* cA = (const char*)g.A + (size_t)cur.pm * tstep; const char* cB = (const char*)g.Bt + (size_t)cur.pn * tstep;
    S.a_ready(cur);
    if constexpr (SP2) {
        PG8_STAGE(PG8_SB(0, 0), cB, voffB); PG8_STAGE(PG8_SB(0, 1), cB + hstep, voffB); PG8_STAGE(PG8_SA(0, 0), cA, voffA); PG8_STAGE(PG8_SA(0, 1), cA + hstep, voffA);
        if (wr == 1) PG8_BAR;
        PG8_WAIT_V(2); PG8_BAR;
        PG8_STAGE(PG8_SB(1, 0), cB + kstep, voffB); PG8_STAGE(PG8_SA(1, 0), cA + kstep, voffA); PG8_STAGE(PG8_SB(1, 1), cB + hstep + kstep, voffB);
        PG8_WAIT_V(6); PG8_BAR;
    } else {
        PG8_STAGE(PG8_SB(0, 0), cB, voffB); PG8_STAGE(PG8_SA(0, 0), cA, voffA); PG8_STAGE(PG8_SB(0, 1), cB + hstep, voffB); PG8_STAGE(PG8_SA(0, 1), cA + hstep, voffA);
        if (wr == 1) PG8_BAR;
        PG8_WAIT_V(4); PG8_BAR;
        PG8_STAGE(PG8_SB(1, 0), cB + kstep, voffB); PG8_STAGE(PG8_SA(1, 0), cA + kstep, voffA); PG8_STAGE(PG8_SB(1, 1), cB + hstep + kstep, voffB);
        PG8_WAIT_V(6); PG8_BAR;
    }
    for (;;) {
        const bool has_next = S.next(ui + 1, nxt);
        const char* nA = has_next ? (const char*)g.A + (size_t)nxt.pm * tstep : cA; const char* nB = has_next ? (const char*)g.Bt + (size_t)nxt.pn * tstep : cB;
        for (int t = 0; t < nt; t += 2) {
            const bool last = (t == nt - 2);
            const char* a1 = cA + (size_t)(t + 1) * kstep;
            const char* a2 = last ? nA : cA + (size_t)(t + 2) * kstep; const char* b2 = last ? nB : cB + (size_t)(t + 2) * kstep;
            const char* a3 = a2 + kstep; const char* b3 = b2 + kstep;
            if (last && has_next) S.a_ready(nxt);
            if constexpr (SP2) {
            PG8_LDB(B0, 0, 0); PG8_LDB(B1, 0, 1); PG8_SCHED; PG8_LDA(At, 0, 0); PG8_STAGE(PG8_SA(1, 1), a1 + hstep, voffA);
            PG8_WAIT_V(8); PG8_WAIT_L(0); PG8_BAR; PG8_MMA(0, 0, At, B0); PG8_MMA(0, 1, At, B1); PG8_BAR; PG8_SCHED;
            PG8_LDA(At, 0, 1); PG8_STAGE(PG8_SB(0, 0), b2, voffB); PG8_STAGE(PG8_SB(0, 1), b2 + hstep, voffB); PG8_STAGE(PG8_SA(0, 0), a2, voffA);
            PG8_WAIT_V(8); PG8_WAIT_L(0); PG8_BAR; PG8_MMA(1, 0, At, B0); PG8_MMA(1, 1, At, B1); PG8_BAR; PG8_SCHED;
            PG8_LDB(B0, 1, 0); PG8_LDB(B1, 1, 1); PG8_SCHED; PG8_LDA(At, 1, 0); PG8_STAGE(PG8_SA(0, 1), a2 + hstep, voffA);
            PG8_WAIT_V(8); PG8_WAIT_L(0); PG8_BAR; PG8_MMA(0, 0, At, B0); PG8_MMA(0, 1, At, B1); PG8_BAR; PG8_SCHED;
            PG8_LDA(At, 1, 1); PG8_STAGE(PG8_SB(1, 0), b3, voffB); PG8_STAGE(PG8_SB(1, 1), b3 + hstep, voffB); PG8_STAGE(PG8_SA(1, 0), a3, voffA);
            PG8_WAIT_V(8); PG8_WAIT_L(0); PG8_BAR; PG8_MMA(1, 0, At, B0); PG8_MMA(1, 1, At, B1); PG8_BAR; PG8_SCHED;
            } else {
            PG8_LDB(B0, 0, 0); PG8_SCHED; PG8_LDA(At, 0, 0); PG8_STAGE(PG8_SA(1, 1), a1 + hstep, voffA);
            PG8_WAIT_L(8); PG8_BAR; PG8_WAIT_L(0); PG8_MMA(0, 0, At, B0); PG8_BAR; PG8_SCHED;
            PG8_LDB(B1, 0, 1); PG8_STAGE(PG8_SB(0, 0), b2, voffB);
            PG8_BAR; PG8_WAIT_L(0); PG8_MMA(0, 1, At, B1); PG8_BAR;
            PG8_LDA(At, 0, 1); PG8_STAGE(PG8_SA(0, 0), a2, voffA);
            PG8_BAR; PG8_WAIT_L(0); PG8_MMA(1, 0, At, B0); PG8_BAR; PG8_SCHED;
            PG8_STAGE(PG8_SB(0, 1), b2 + hstep, voffB);
            PG8_WAIT_V(6); PG8_BAR; PG8_MMA(1, 1, At, B1); PG8_BAR;
            PG8_LDB(B0, 1, 0); PG8_SCHED; PG8_LDA(At, 1, 0); PG8_STAGE(PG8_SA(0, 1), a2 + hstep, voffA);
            PG8_WAIT_L(8); PG8_BAR; PG8_WAIT_L(0); PG8_MMA(0, 0, At, B0); PG8_BAR; PG8_SCHED;
            PG8_LDB(B1, 1, 1); PG8_STAGE(PG8_SB(1, 0), b3, voffB);
            PG8_BAR; PG8_WAIT_L(0); PG8_MMA(0, 1, At, B1); PG8_BAR;
            PG8_LDA(At, 1, 1); PG8_STAGE(PG8_SA(1, 0), a3, voffA);
            PG8_BAR; PG8_WAIT_L(0); PG8_MMA(1, 0, At, B0); PG8_BAR; PG8_SCHED;
            PG8_STAGE(PG8_SB(1, 1), b3 + hstep, voffB);
            PG8_WAIT_V(6); PG8_BAR; PG8_MMA(1, 1, At, B1); PG8_BAR;
            }
        }
        if constexpr (ALIGN_EPI) { if (wr == 0) PG8_BAR; }
        if constexpr (!Epi::AFTER_DRAIN) { E(acc, cur, wr, wc, fr, fq); S.done(cur); }
        if (!has_next) break;
#pragma unroll
        for (int a = 0; a < 2; ++a)
#pragma unroll
            for (int b = 0; b < 2; ++b)
#pragma unroll
                for (int m = 0; m < 4; ++m)
#pragma unroll
                    for (int n = 0; n < 2; ++n) acc[a][b][m][n] = (f32x4){0.f, 0.f, 0.f, 0.f};
        cur = nxt; cA = nA; cB = nB; ++ui;
        if constexpr (ALIGN_EPI) { if (wr == 1) PG8_BAR; }
    }
    PG8_WAIT_V(0);
    if constexpr (!ALIGN_EPI) { if (wr == 0) PG8_BAR; }
    PG8_BAR;
    if constexpr (Epi::AFTER_DRAIN) { E.fused(acc, cur, wr, wc, fr, fq, lds, wid, lane); S.done(cur); }
#undef PG8_SA
#undef PG8_SB
#undef PG8_STAGE
#undef PG8_LDA
#undef PG8_LDB
#undef PG8_MMA
#undef PG8_WAIT_V
#undef PG8_WAIT_L
#undef PG8_BAR
#undef PG8_SCHED
}
}
namespace pg8 {
__device__ __forceinline__ float fsigmoid(float x) { return __builtin_amdgcn_rcpf(1.0f + __expf(-x)); }
struct EpiF32 {
    static constexpr bool PERM = false, AFTER_DRAIN = false;
    float* C; int ldc;
    __device__ __forceinline__ void operator()(const f32x4 (&acc)[2][2][4][2], const Unit& u, int wr, int wc, int fr, int fq) const {
        const int row0 = u.pm * BM + wr * 64 + fr, col0 = u.pn * BM + wc * 32 + 4 * fq;
#pragma unroll
        for (int ai = 0; ai < 2; ++ai)
#pragma unroll
            for (int m = 0; m < 4; ++m) { float* rowp = C + (size_t)(row0 + ai * HALF + m * 16) * ldc + col0;
#pragma unroll
                for (int bj = 0; bj < 2; ++bj)
#pragma unroll
                    for (int n = 0; n < 2; ++n) *(f32x4*)(rowp + bj * HALF + n * 16) = acc[ai][bj][m][n]; }
    }
};
struct EpiBf16 {
    static constexpr bool PERM = true, AFTER_DRAIN = false;
    bf16_t* O; int ldc;
    __device__ __forceinline__ void operator()(const f32x4 (&acc)[2][2][4][2], const Unit& u, int wr, int wc, int fr, int fq) const {
        const int row0 = u.pm * BM + wr * 64 + fr, col0 = u.pn * BM + wc * 32 + 8 * fq;
#pragma unroll
        for (int ai = 0; ai < 2; ++ai)
#pragma unroll
            for (int m = 0; m < 4; ++m) { bf16_t* rowp = O + (size_t)(row0 + ai * HALF + m * 16) * ldc + col0;
#pragma unroll
                for (int bj = 0; bj < 2; ++bj) { const f32x4 v0 = acc[ai][bj][m][0], v1 = acc[ai][bj][m][1];
                    u32x4 w; w.x = cvt_pk_bf16(v0[0], v0[1]); w.y = cvt_pk_bf16(v0[2], v0[3]); w.z = cvt_pk_bf16(v1[0], v1[1]); w.w = cvt_pk_bf16(v1[2], v1[3]);
                    *(u32x4*)(rowp + bj * HALF) = w; } }
    }
};
struct EpiHgrn {
    static constexpr bool PERM = true, AFTER_DRAIN = false;
    unsigned char* Ub; const float* lbs; int layer_j;
    __device__ __forceinline__ void operator()(const f32x4 (&acc)[2][2][4][2], const Unit& u, int wr, int wc, int fr, int fq) const {
        const int seg = u.pn >> 3, colt = (u.pn & 7) * BM;
        const int row0 = u.pm * BM + wr * 64 + fr, col0 = colt + wc * 32 + 8 * fq;
        if (seg == 1 || seg == 2) {
            const int dir = seg - 1; float* LF = (float*)(Ub + ((size_t)(96 + 64 * dir) << 20));
#pragma unroll
            for (int bj = 0; bj < 2; ++bj) {
                float lb[8];
#pragma unroll
                for (int e = 0; e < 8; ++e) lb[e] = 0.f;
                if (layer_j == 1) {
                    const f32x4 a0 = *(const f32x4*)(lbs + (size_t)(dir * 2 + 0) * 2048 + col0 + bj * HALF), a1 = *(const f32x4*)(lbs + (size_t)(dir * 2 + 0) * 2048 + col0 + bj * HALF + 4);
                    const f32x4 b0 = *(const f32x4*)(lbs + (size_t)(dir * 2 + 1) * 2048 + col0 + bj * HALF), b1 = *(const f32x4*)(lbs + (size_t)(dir * 2 + 1) * 2048 + col0 + bj * HALF + 4);
#pragma unroll
                    for (int e = 0; e < 4; ++e) { lb[e] = fsigmoid(b0[e] - a0[e]); lb[4 + e] = fsigmoid(b1[e] - a1[e]); }
                }
#pragma unroll
                for (int ai = 0; ai < 2; ++ai)
#pragma unroll
                    for (int m = 0; m < 4; ++m) { float* rowp = LF + (size_t)(row0 + ai * HALF + m * 16) * 2048 + col0 + bj * HALF;
#pragma unroll
                        for (int n = 0; n < 2; ++n) { f32x4 o;
#pragma unroll
                            for (int e = 0; e < 4; ++e) { const float s = fsigmoid(acc[ai][bj][m][n][e]); const float l = lb[4 * n + e]; o[e] = __logf(l + (1.0f - l) * s); }
                            *(f32x4*)(rowp + 4 * n) = o; } }
            }
        } else {
            const int sel = (seg == 0) ? 0 : ((seg == 3) ? 1 : 2); bf16_t* O = (bf16_t*)(Ub + ((size_t)(32 * sel) << 20)); const bool act = (seg != 3);
#pragma unroll
            for (int ai = 0; ai < 2; ++ai)
#pragma unroll
                for (int m = 0; m < 4; ++m) { bf16_t* rowp = O + (size_t)(row0 + ai * HALF + m * 16) * 2048 + col0;
#pragma unroll
                    for (int bj = 0; bj < 2; ++bj) { f32x4 v0 = acc[ai][bj][m][0], v1 = acc[ai][bj][m][1];
                        if (act) {
#pragma unroll
                            for (int e = 0; e < 4; ++e) { v0[e] = v0[e] * fsigmoid(v0[e]); v1[e] = v1[e] * fsigmoid(v1[e]); } }
                        u32x4 w; w.x = cvt_pk_bf16(v0[0], v0[1]); w.y = cvt_pk_bf16(v0[2], v0[3]); w.z = cvt_pk_bf16(v1[0], v1[1]); w.w = cvt_pk_bf16(v1[2], v1[3]);
                        *(u32x4*)(rowp + bj * HALF) = w; } }
        }
    }
};
}
#define GAS __attribute__((address_space(1)))
#define LAS __attribute__((address_space(3)))
typedef unsigned short bf16;
typedef unsigned v4u __attribute__((ext_vector_type(4)));
typedef unsigned v2u __attribute__((ext_vector_type(2)));
typedef float f32x4 __attribute__((ext_vector_type(4)));
typedef short bf16x8 __attribute__((ext_vector_type(8)));
constexpr int NWAVES = 8, NTHR = 512;
constexpr int D = 2048, BATCH = 2, SEQ = 4096, M = BATCH * SEQ, DEPTH = 4, NH = 16, HK = 128, FF = 5632;
constexpr int N_HG = 5 * D, N_SC = 3 * D, N_FI = 2 * FF;
constexpr float EPS = 1e-6f;
constexpr size_t MiB = 1u << 20;
constexpr size_t WS_CTL = 0, WS_WHGI = 2 * MiB, WS_WHGO = 82 * MiB, WS_WSCI = 98 * MiB, WS_WSCO = 146 * MiB, WS_WFI = 162 * MiB, WS_WFO = 338 * MiB;
constexpr size_t WS_X = 426 * MiB, WS_XN = 490 * MiB, WS_MBUF = 522 * MiB, WS_U = 586 * MiB, WS_ACT = 810 * MiB, WS_REC = 898 * MiB, WS_END = 1286 * MiB;
constexpr size_t U_Q = 0, U_V = 32 * MiB, U_G = 64 * MiB, U_LFF = 96 * MiB, U_LFB = 160 * MiB;
constexpr int LDS_BYTES = 147456;

__device__ __forceinline__ unsigned f2bf(float f) { unsigned u = __builtin_bit_cast(unsigned, f); return (u + 0x7fffu + ((u >> 16) & 1u)) >> 16; }
__device__ __forceinline__ unsigned pk2(float lo, float hi) { return f2bf(lo) | (f2bf(hi) << 16); }
__device__ __forceinline__ float bflo(unsigned w) { return __builtin_bit_cast(float, w << 16); }
__device__ __forceinline__ float bfhi(unsigned w) { return __builtin_bit_cast(float, w & 0xffff0000u); }
__device__ __forceinline__ float bf2f(bf16 b) { return __builtin_bit_cast(float, ((unsigned)b) << 16); }
__device__ __forceinline__ float shx(float v, int o, int lane) { return __builtin_bit_cast(float, __builtin_amdgcn_ds_bpermute((lane ^ o) << 2, __builtin_bit_cast(int, v))); }
__device__ __forceinline__ float wave_sum(float v, int lane) {
#pragma unroll
    for (int o = 1; o < 64; o <<= 1) v += shx(v, o, lane);
    return v;
}
__device__ __forceinline__ float fsig(float x) { return __builtin_amdgcn_rcpf(1.0f + __expf(-x)); }
#define LDS_WAIT() asm volatile("s_waitcnt lgkmcnt(0)" ::: "memory")

__device__ __forceinline__ void p0_transpose_item(const float* W, int K, int N, bf16* WT, LAS float* scr, int item, int lane) {
    const int nblk = N / 32, kb = item / nblk, nb = item % nblk, k0 = 64 * kb, n0 = 32 * nb;
#pragma unroll 8
    for (int i = 0; i < 32; ++i) { const int kk = 2 * i + (lane >> 5); scr[kk * 33 + (lane & 31)] = W[(size_t)(k0 + kk) * N + n0 + (lane & 31)]; }
    LDS_WAIT(); asm volatile("" ::: "memory");
    const int c = lane & 7;
#pragma unroll
    for (int j = 0; j < 4; ++j) { const int n = (lane >> 3) + 8 * j; const LAS float* s = scr + (8 * c) * 33 + n;
        v4u o; o.x = pk2(s[0 * 33], s[1 * 33]); o.y = pk2(s[2 * 33], s[3 * 33]); o.z = pk2(s[4 * 33], s[5 * 33]); o.w = pk2(s[6 * 33], s[7 * 33]);
        *(v4u*)(WT + (size_t)(n0 + n) * K + k0 + 8 * c) = o; }
    LDS_WAIT(); asm volatile("" ::: "memory");
}
__device__ __forceinline__ void transpose_matrix(const float* W, int K, int N, bf16* WT, LAS float* scr, int gw, int NGW, int lane) {
    const int items = (K / 64) * (N / 32);
    for (int it = gw; it < items; it += NGW) p0_transpose_item(W, K, N, WT, scr, it, lane);
}

__device__ __forceinline__ void unpack8(const v4u a, float (&f)[8]) { f[0] = bflo(a.x); f[1] = bfhi(a.x); f[2] = bflo(a.y); f[3] = bfhi(a.y); f[4] = bflo(a.z); f[5] = bfhi(a.z); f[6] = bflo(a.w); f[7] = bfhi(a.w); }
__device__ __forceinline__ v4u pack8(const float (&f)[8]) { v4u o; o.x = pk2(f[0], f[1]); o.y = pk2(f[2], f[3]); o.z = pk2(f[4], f[5]); o.w = pk2(f[6], f[7]); return o; }

template <bool XF32>
__device__ __forceinline__ void rownorm_phase(const void* xin, const bf16* mb, const float* w_post, const float* w_next, bf16* xout, float* fout, bf16* xn, int gw, int NGW, int lane) {
    for (int m = gw; m < M; m += NGW) {
        float x[4][8];
#pragma unroll
        for (int j = 0; j < 4; ++j) {
            if (XF32) { const f32x4* xr = (const f32x4*)((const float*)xin + (size_t)m * D + 8 * lane + 512 * j); const f32x4 a = xr[0], b = xr[1];
                x[j][0] = a.x; x[j][1] = a.y; x[j][2] = a.z; x[j][3] = a.w; x[j][4] = b.x; x[j][5] = b.y; x[j][6] = b.z; x[j][7] = b.w; }
            else unpack8(*(const v4u*)((const bf16*)xin + (size_t)m * D + 8 * lane + 512 * j), x[j]);
        }
        if (mb) {
            float mm[4][8]; float ss = 0.f;
#pragma unroll
            for (int j = 0; j < 4; ++j) { unpack8(*(const v4u*)(mb + (size_t)m * D + 8 * lane + 512 * j), mm[j]);
#pragma unroll
                for (int e = 0; e < 8; ++e) ss += mm[j][e] * mm[j][e]; }
            const float rstd = __builtin_amdgcn_rsqf(wave_sum(ss, lane) * (1.f / D) + EPS);
#pragma unroll
            for (int j = 0; j < 4; ++j) { const f32x4 w0 = *(const f32x4*)(w_post + 8 * lane + 512 * j), w1 = *(const f32x4*)(w_post + 8 * lane + 512 * j + 4);
                x[j][0] += mm[j][0] * rstd * w0.x; x[j][1] += mm[j][1] * rstd * w0.y; x[j][2] += mm[j][2] * rstd * w0.z; x[j][3] += mm[j][3] * rstd * w0.w;
                x[j][4] += mm[j][4] * rstd * w1.x; x[j][5] += mm[j][5] * rstd * w1.y; x[j][6] += mm[j][6] * rstd * w1.z; x[j][7] += mm[j][7] * rstd * w1.w; }
        }
        if (xout) {
#pragma unroll
            for (int j = 0; j < 4; ++j) *(v4u*)(xout + (size_t)m * D + 8 * lane + 512 * j) = pack8(x[j]); }
        if (fout) {
#pragma unroll
            for (int j = 0; j < 4; ++j) { f32x4* o = (f32x4*)(fout + (size_t)m * D + 8 * lane + 512 * j); o[0] = (f32x4){x[j][0], x[j][1], x[j][2], x[j][3]}; o[1] = (f32x4){x[j][4], x[j][5], x[j][6], x[j][7]}; } }
        if (xn) {
            float s2 = 0.f;
#pragma unroll
            for (int j = 0; j < 4; ++j)
#pragma unroll
                for (int e = 0; e < 8; ++e) s2 += x[j][e] * x[j][e];
            const float r2 = __builtin_amdgcn_rsqf(wave_sum(s2, lane) * (1.f / D) + EPS);
#pragma unroll
            for (int j = 0; j < 4; ++j) { const f32x4 w0 = *(const f32x4*)(w_next + 8 * lane + 512 * j), w1 = *(const f32x4*)(w_next + 8 * lane + 512 * j + 4);
                float y[8] = {x[j][0] * r2 * w0.x, x[j][1] * r2 * w0.y, x[j][2] * r2 * w0.z, x[j][3] * r2 * w0.w, x[j][4] * r2 * w1.x, x[j][5] * r2 * w1.y, x[j][6] * r2 * w1.z, x[j][7] * r2 * w1.w};
                *(v4u*)(xn + (size_t)m * D + 8 * lane + 512 * j) = pack8(y); }
        }
    }
}

typedef pg8::bf16x8 bfx8;
#define MFMA16(a, b, c) __builtin_amdgcn_mfma_f32_16x16x32_bf16(a, b, c, 0, 0, 0)
constexpr int QS = 136, TS = 72;
constexpr int OSS = 132;
constexpr int L_QD = 0, L_QH = 64 * QS * 2, L_KH = 2 * 64 * QS * 2, L_VT = 3 * 64 * QS * 2, L_AM = L_VT + 128 * TS * 2, L_OS = L_AM + 64 * TS * 2, L_TOT = L_OS + 64 * OSS * 4, L_RECEND = L_TOT + 2048;
static_assert(L_RECEND <= 131072, "LDS map of the recurrence passes");
constexpr size_t REC_UT = 0, REC_ST = 256 * MiB, REC_DEC = 384 * MiB;

__device__ __forceinline__ void chunk_cumsum(const float* LFbase, int t0, int dir, int k, int ig, LAS float* TOT, float (&lf)[16], float (&bb)[16], float& blast, float& r31) {
#pragma unroll
    for (int j = 0; j < 16; ++j) { const int i = 16 * ig + j; const int t = dir ? (t0 + 63 - i) : (t0 + i); lf[j] = LFbase[(unsigned)(t * D + k)]; }
    float run = 0.f;
#pragma unroll
    for (int j = 0; j < 16; ++j) { run += lf[j]; bb[j] = run; }
    TOT[ig * 128 + k] = run;
    __syncthreads();
    const float s0 = TOT[k], s1 = TOT[128 + k], s2 = TOT[256 + k], s3 = TOT[384 + k];
    const float base = (ig > 0 ? s0 : 0.f) + (ig > 1 ? s1 : 0.f) + (ig > 2 ? s2 : 0.f);
#pragma unroll
    for (int j = 0; j < 16; ++j) bb[j] += base;
    blast = (s0 + s1) + (s2 + s3); r31 = s0 + s1;
}
__device__ __forceinline__ void gather_col(const bf16* base, int t0, int dir, int col, int ig, unsigned (&w)[8]) {
#pragma unroll
    for (int j = 0; j < 8; ++j) { const int i = 16 * ig + 2 * j; const int ta = dir ? (t0 + 63 - i) : (t0 + i), tb = dir ? (ta - 1) : (ta + 1);
        w[j] = (unsigned)base[(unsigned)(ta * D + col)] | ((unsigned)base[(unsigned)(tb * D + col)] << 16); }
}
__device__ __forceinline__ void store_colT(const unsigned (&w)[8], int col, int ig, LAS bf16* T) {
    LAS v4u* o = (LAS v4u*)(T + col * TS + 16 * ig);
    v4u o0, o1; o0.x = w[0]; o0.y = w[1]; o0.z = w[2]; o0.w = w[3]; o1.x = w[4]; o1.y = w[5]; o1.z = w[6]; o1.w = w[7];
    o[0] = o0; o[1] = o1;
}
__device__ __forceinline__ void rec_pass1(LAS unsigned char* lds, const bf16* V, const float* LFf, const float* LFb, float* UT, float* DEC, int tid) {
    const int lane = tid & 63, wave = __builtin_amdgcn_readfirstlane(tid >> 6), k = tid & 127, ig = tid >> 7, fr = lane & 15, fq = lane >> 4;
    LAS bf16* KT = (LAS bf16*)(lds + L_QD); LAS bf16* VT = (LAS bf16*)(lds + L_VT); LAS float* TOT = (LAS float*)(lds + L_TOT);
    for (int task = blockIdx.x; task < 4096; task += gridDim.x) {
        const int c = task & 63, seq = task >> 6, h = seq & 15, b = (seq >> 4) & 1, dir = seq >> 5;
        const int t0 = 64 * (dir ? 63 - c : c);
        const float* LFbase = (dir ? LFb : LFf) + (size_t)b * SEQ * D + h * HK;
        float lf[16], bb[16], blast, r31;
        unsigned vw[8]; gather_col(V + (size_t)b * SEQ * D + h * HK, t0, dir, k, ig, vw);
        chunk_cumsum(LFbase, t0, dir, k, ig, TOT, lf, bb, blast, r31);
        unsigned w[8];
#pragma unroll
        for (int j = 0; j < 8; ++j) { const float k0 = (1.0f - __expf(lf[2 * j])) * __expf(blast - bb[2 * j]), k1 = (1.0f - __expf(lf[2 * j + 1])) * __expf(blast - bb[2 * j + 1]); w[j] = pk2(k0, k1); }
        { LAS v4u* o = (LAS v4u*)(KT + k * TS + 16 * ig); v4u o0, o1; o0.x = w[0]; o0.y = w[1]; o0.z = w[2]; o0.w = w[3]; o1.x = w[4]; o1.y = w[5]; o1.z = w[6]; o1.w = w[7]; o[0] = o0; o[1] = o1; }
        store_colT(vw, k, ig, VT);
        if (ig == 0) DEC[(size_t)task * 128 + k] = __expf(blast);
        __syncthreads();
        f32x4 acc[8];
#pragma unroll
        for (int n = 0; n < 8; ++n) acc[n] = (f32x4){0.f, 0.f, 0.f, 0.f};
#pragma unroll
        for (int ks = 0; ks < 2; ++ks) {
            const bfx8 a = *(const LAS bfx8*)(VT + (16 * wave + fr) * TS + 32 * ks + 8 * fq);
#pragma unroll
            for (int n = 0; n < 8; ++n) { const bfx8 bt = *(const LAS bfx8*)(KT + (16 * n + fr) * TS + 32 * ks + 8 * fq); acc[n] = MFMA16(bt, a, acc[n]); }
        }
        float* o = UT + (size_t)task * 16384 + (16 * wave + fr) * 128 + 4 * fq;
#pragma unroll
        for (int n = 0; n < 8; ++n) *(f32x4*)(o + 16 * n) = acc[n];
        __syncthreads();
    }
}
__device__ __forceinline__ void rec_pass2(const float* UT, const float* DEC, bf16* ST, int gtid, int NT) {
    for (int item = gtid; item < 64 * 4096; item += NT) {
        const int seq = item >> 12, e4 = (item & 4095) * 4, k4 = e4 & 127;
        const float* up = UT + (size_t)seq * 64 * 16384 + e4; const float* dp = DEC + (size_t)seq * 64 * 128 + k4; bf16* sp = ST + (size_t)seq * 64 * 16384 + e4;
        f32x4 s = (f32x4){0.f, 0.f, 0.f, 0.f};
#pragma unroll 8
        for (int c = 0; c < 64; ++c) {
            const f32x4 u = *(const f32x4*)(up + (size_t)c * 16384); const f32x4 d = *(const f32x4*)(dp + c * 128);
            v2u o; o.x = pk2(s.x, s.y); o.y = pk2(s.z, s.w); *(v2u*)(sp + (size_t)c * 16384) = o;
            s = d * s + u;
        }
    }
}
__device__ __forceinline__ void rec_pass3(LAS unsigned char* lds, const bf16* Q, const bf16* V, const bf16* Gt, const float* LFf, const float* LFb, const bf16* ST, const float* gnw, bf16* Yo, int tid) {
    const int lane = tid & 63, wave = __builtin_amdgcn_readfirstlane(tid >> 6), k = tid & 127, ig = tid >> 7, fr = lane & 15, fq = lane >> 4;
    LAS bf16* QDl = (LAS bf16*)(lds + L_QD); LAS bf16* QHl = (LAS bf16*)(lds + L_QH); LAS bf16* KHl = (LAS bf16*)(lds + L_KH); LAS bf16* VT = (LAS bf16*)(lds + L_VT);
    LAS bf16* AM = (LAS bf16*)(lds + L_AM); LAS float* OS = (LAS float*)(lds + L_OS); LAS float* TOT = (LAS float*)(lds + L_TOT);
    for (int task = blockIdx.x; task < 2048; task += gridDim.x) {
        const int C = task & 63, h = (task >> 6) & 15, b = task >> 10, t0 = 64 * C;
        const size_t goff = (size_t)(b * SEQ + t0 + (tid >> 3)) * D + h * HK + 16 * (tid & 7);
        const v4u gq0 = *(const v4u*)(Gt + goff), gq1 = *(const v4u*)(Gt + goff + 8);
#pragma unroll 1
        for (int dir = 0; dir < 2; ++dir) {
            const int c = dir ? 63 - C : C, seq = (dir * 2 + b) * 16 + h;
            const float* LFbase = (dir ? LFb : LFf) + (size_t)b * SEQ * D + h * HK;
            float lf[16], bb[16], blast, r31;
            const int it_b = wave & 3, vh_b = wave >> 2;
            const bf16* STt = ST + ((size_t)seq * 64 + c) * 16384;
            bfx8 stf[4][4];
#pragma unroll
            for (int ks = 0; ks < 2; ++ks)
#pragma unroll
                for (int n = 0; n < 4; ++n) stf[ks][n] = *(const bfx8*)(STt + (unsigned)((64 * vh_b + 16 * n + fr) * 128 + 32 * ks + 8 * fq));
            const bf16* Qbase = Q + (size_t)b * SEQ * D + h * HK;
            unsigned qw[16];
#pragma unroll
            for (int j = 0; j < 16; ++j) { const int i = 16 * ig + j; const int t = dir ? (t0 + 63 - i) : (t0 + i); qw[j] = Qbase[(unsigned)(t * D + k)]; }
            unsigned vw[8]; gather_col(V + (size_t)b * SEQ * D + h * HK, t0, dir, k, ig, vw);
            chunk_cumsum(LFbase, t0, dir, k, ig, TOT, lf, bb, blast, r31);
#pragma unroll
            for (int j = 0; j < 16; ++j) { const int i = 16 * ig + j;
                const float qv = bf2f((bf16)qw[j]);
                const float eb = __expf(bb[j]), e1 = __expf(bb[j] - r31), e2 = __expf(r31 - bb[j]), kk = 1.0f - __expf(lf[j]);
                QDl[i * QS + k] = (bf16)f2bf(qv * eb); QHl[i * QS + k] = (bf16)f2bf(qv * e1); KHl[i * QS + k] = (bf16)f2bf(kk * e2); }
            store_colT(vw, k, ig, VT);
            __syncthreads();
#pragma unroll
            for (int ks = 2; ks < 4; ++ks)
#pragma unroll
                for (int n = 0; n < 4; ++n) stf[ks][n] = *(const bfx8*)(STt + (unsigned)((64 * vh_b + 16 * n + fr) * 128 + 32 * ks + 8 * fq));
            {
                const int it = wave >> 1;
#pragma unroll
                for (int jj = 0; jj < 2; ++jj) { const int jt = 2 * (wave & 1) + jj;
                    f32x4 a4 = (f32x4){0.f, 0.f, 0.f, 0.f};
                    if (jt <= it) {
#pragma unroll
                        for (int ks = 0; ks < 4; ++ks) { const bfx8 a = *(const LAS bfx8*)(QHl + (16 * it + fr) * QS + 32 * ks + 8 * fq); const bfx8 bt = *(const LAS bfx8*)(KHl + (16 * jt + fr) * QS + 32 * ks + 8 * fq); a4 = MFMA16(bt, a, a4); }
                    }
                    const int ii = 16 * it + fr, j0 = 16 * jt + 4 * fq;
                    const float m0 = (jt <= it && j0 + 0 <= ii) ? a4.x : 0.f, m1 = (jt <= it && j0 + 1 <= ii) ? a4.y : 0.f, m2 = (jt <= it && j0 + 2 <= ii) ? a4.z : 0.f, m3 = (jt <= it && j0 + 3 <= ii) ? a4.w : 0.f;
                    v2u o; o.x = pk2(m0, m1); o.y = pk2(m2, m3); *(LAS v2u*)(AM + ii * TS + j0) = o; }
            }
            __syncthreads();
            {
                const int it = it_b, vh = vh_b;
                f32x4 o4[4];
#pragma unroll
                for (int n = 0; n < 4; ++n) o4[n] = (f32x4){0.f, 0.f, 0.f, 0.f};
#pragma unroll
                for (int ks = 0; ks < 4; ++ks) { const bfx8 a = *(const LAS bfx8*)(QDl + (16 * it + fr) * QS + 32 * ks + 8 * fq);
#pragma unroll
                    for (int n = 0; n < 4; ++n) o4[n] = MFMA16(stf[ks][n], a, o4[n]); }
#pragma unroll
                for (int ks = 0; ks < 2; ++ks) { const bfx8 a = *(const LAS bfx8*)(AM + (16 * it + fr) * TS + 32 * ks + 8 * fq);
#pragma unroll
                    for (int n = 0; n < 4; ++n) { const bfx8 bt = *(const LAS bfx8*)(VT + (64 * vh + 16 * n + fr) * TS + 32 * ks + 8 * fq); o4[n] = MFMA16(bt, a, o4[n]); } }
                const int i = 16 * it + fr, tl = dir ? 63 - i : i;
#pragma unroll
                for (int n = 0; n < 4; ++n) { LAS f32x4* p = (LAS f32x4*)(OS + tl * OSS + 64 * vh + 16 * n + 4 * fq); if (dir == 0) *p = o4[n]; else *p = *p + o4[n]; }
            }
            __syncthreads();
        }
        {
            const int row = tid >> 3, vseg = tid & 7;
            const LAS f32x4* p = (const LAS f32x4*)(OS + row * OSS + 16 * vseg);
            f32x4 o[4]; float ss = 0.f;
#pragma unroll
            for (int x4 = 0; x4 < 4; ++x4) { o[x4] = p[x4]; ss += (o[x4].x * o[x4].x + o[x4].y * o[x4].y) + (o[x4].z * o[x4].z + o[x4].w * o[x4].w); }
            ss += shx(ss, 1, lane); ss += shx(ss, 2, lane); ss += shx(ss, 4, lane);
            const float r = __builtin_amdgcn_rsqf(ss * (1.f / HK) + EPS);
            float g[8], y[8];
#pragma unroll
            for (int hh = 0; hh < 2; ++hh) { unpack8(hh ? gq1 : gq0, g);
                const f32x4 w0 = *(const f32x4*)(gnw + 16 * vseg + 8 * hh), w1 = *(const f32x4*)(gnw + 16 * vseg + 8 * hh + 4);
                const f32x4 oa = o[2 * hh], ob = o[2 * hh + 1];
                y[0] = oa.x * r * w0.x * g[0]; y[1] = oa.y * r * w0.y * g[1]; y[2] = oa.z * r * w0.z * g[2]; y[3] = oa.w * r * w0.w * g[3];
                y[4] = ob.x * r * w1.x * g[4]; y[5] = ob.y * r * w1.y * g[5]; y[6] = ob.z * r * w1.z * g[6]; y[7] = ob.w * r * w1.w * g[7];
                *(v4u*)(Yo + goff + 8 * hh) = pack8(y); }
        }
    }
}

__device__ __forceinline__ void sconv_phase(const bf16* U, const float* wc, bf16* Y, int gtid, int NT) {
    for (int idx = gtid; idx < M * (D / 8); idx += NT) {
        const int m = idx >> 8, c0 = (idx & 255) * 8, tp = m & (SEQ - 1);
        float w0[8], w1[8], w2[8];
#pragma unroll
        for (int e = 0; e < 8; ++e) { w0[e] = wc[c0 + e]; w1[e] = wc[D + c0 + e]; w2[e] = wc[2 * D + c0 + e]; }
        const bf16* r = U + (size_t)m * N_SC + c0;
        float gb[8], c[8], x[8], z[8];
        unpack8(*(const v4u*)(r), gb); unpack8(*(const v4u*)(r + D), c); unpack8(*(const v4u*)(r + 2 * D), x);
#pragma unroll
        for (int e = 0; e < 8; ++e) z[e] = w1[e] * (c[e] * x[e]);
        if (tp > 0) { unpack8(*(const v4u*)(r - N_SC + D), c); unpack8(*(const v4u*)(r - N_SC + 2 * D), x);
#pragma unroll
            for (int e = 0; e < 8; ++e) z[e] += w0[e] * (c[e] * x[e]); }
        if (tp < SEQ - 1) { unpack8(*(const v4u*)(r + N_SC + D), c); unpack8(*(const v4u*)(r + N_SC + 2 * D), x);
#pragma unroll
            for (int e = 0; e < 8; ++e) z[e] += w2[e] * (c[e] * x[e]); }
#pragma unroll
        for (int e = 0; e < 8; ++e) z[e] *= gb[e];
        *(v4u*)(Y + (size_t)m * D + c0) = pack8(z);
    }
}

__device__ __forceinline__ void ffnact_phase(const bf16* UP, const float* wc, bf16* ACT, int gtid, int NT) {
    constexpr int CB = FF / 8;
    for (int idx = gtid; idx < M * CB; idx += NT) {
        const int m = idx / CB, c0 = (idx - m * CB) * 8, tp = m & (SEQ - 1);
        const bf16* r = UP + (size_t)m * N_FI + c0;
        float g[8], v[8], a[8], b[8];
        unpack8(*(const v4u*)(r), a); unpack8(*(const v4u*)(r + FF), b);
#pragma unroll
        for (int e = 0; e < 8; ++e) { g[e] = wc[N_FI + c0 + e] * a[e]; v[e] = wc[N_FI + FF + c0 + e] * b[e]; }
        if (tp > 0) { unpack8(*(const v4u*)(r - N_FI), a); unpack8(*(const v4u*)(r - N_FI + FF), b);
#pragma unroll
            for (int e = 0; e < 8; ++e) { g[e] += wc[c0 + e] * a[e]; v[e] += wc[FF + c0 + e] * b[e]; } }
        if (tp < SEQ - 1) { unpack8(*(const v4u*)(r + N_FI), a); unpack8(*(const v4u*)(r + N_FI + FF), b);
#pragma unroll
            for (int e = 0; e < 8; ++e) { g[e] += wc[2 * N_FI + c0 + e] * a[e]; v[e] += wc[2 * N_FI + FF + c0 + e] * b[e]; } }
#pragma unroll
        for (int e = 0; e < 8; ++e) g[e] = g[e] * fsig(g[e]) * v[e];
        *(v4u*)(ACT + (size_t)m * FF + c0) = pack8(g);
    }
}

#define XB_TMO      128
#define XB_XCNT(j)  (256  + 64 * (j))
#define XB_XSUB(j)  (1280 + 64 * (j))
#define XB_XGEN(j)  (2304 + 64 * (j))
#define XB_TOP      3328
#define XB_TOPGEN   3392
#define XCD_BAR_WORDS 3456
#define XB_SPIN_CAP (1u << 18)

__device__ __forceinline__ unsigned xb_ld(unsigned* p)              { return __hip_atomic_load(p, __ATOMIC_RELAXED, __HIP_MEMORY_SCOPE_AGENT); }
__device__ __forceinline__ unsigned xb_add(unsigned* p, unsigned v) { return __hip_atomic_fetch_add(p, v, __ATOMIC_RELAXED, __HIP_MEMORY_SCOPE_AGENT); }
__device__ __forceinline__ unsigned xb_xcc_id() { return (unsigned)__builtin_amdgcn_s_getreg((3 << 11) | 20) & 0xFu; }
#define XB_SPIN(cond, bar) do { unsigned _sp = 0; while (cond) { __builtin_amdgcn_s_sleep(1); \
    if ((++_sp & 255u) == 0u) { if (xb_ld(&(bar)[XB_TMO])) break; if (_sp > XB_SPIN_CAP) { atomicAdd(&(bar)[XB_TMO], 1u); break; } } } } while (0)

struct XcdBarrier {
    unsigned* bar; unsigned x;
    volatile LAS unsigned* st;
};

__device__ __forceinline__ XcdBarrier xcd_barrier_post(unsigned* bar, volatile LAS unsigned* st) {
    XcdBarrier b; b.bar = bar; b.x = xb_xcc_id(); b.st = st;
    if (threadIdx.x == 0) (void)xb_add(&bar[XB_XCNT(b.x)], 1u);
    return b;
}
__device__ __forceinline__ void xcd_barrier_complete(unsigned* bar, unsigned x, unsigned& nloc, unsigned& nx) {
    const unsigned G = gridDim.x * gridDim.y * gridDim.z;
    unsigned sum, cnt, mine, sp = 0u;
    for (;;) {
        sum = 0u; cnt = 0u; mine = 0u;
#pragma unroll 1
        for (unsigned j = 0; j < 16; ++j) { const unsigned c = xb_ld(&bar[XB_XCNT(j)]); sum += c; cnt += (c > 0u) ? 1u : 0u; mine = (j == x) ? c : mine; }
        if (sum == G) break;
        __builtin_amdgcn_s_sleep(1);
        if ((++sp & 255u) == 0u) { if (xb_ld(&bar[XB_TMO])) break; if (sp > XB_SPIN_CAP) { atomicAdd(&bar[XB_TMO], 1u); break; } }
    }
    nloc = mine > 0u ? mine : 1u; nx = cnt > 0u ? cnt : 1u;
}

__device__ __forceinline__ void xcd_barrier(const XcdBarrier& b) {
    asm volatile("s_waitcnt vmcnt(0)" ::: "memory");
    __syncthreads();
    if (threadIdx.x == 0) {
        unsigned* bar = b.bar; asm volatile("" : "+s"(bar));
        __builtin_amdgcn_s_waitcnt(0);
        unsigned nloc = b.st[0], nx = b.st[1];
        if (nloc == 0u) { xcd_barrier_complete(bar, b.x, nloc, nx); b.st[0] = nloc; b.st[1] = nx; }
        const unsigned old = xb_add(&bar[XB_XSUB(b.x)], 1u);
        const unsigned gen = old / nloc;
        if (old + 1u == (gen + 1u) * nloc) {
            __builtin_amdgcn_fence(__ATOMIC_RELEASE, "agent");
            asm volatile("s_waitcnt vmcnt(0)" ::: "memory");
            const unsigned og = xb_add(&bar[XB_TOP], 1u);
            const unsigned tg = og / nx;
            if (og + 1u == (tg + 1u) * nx) xb_add(&bar[XB_TOPGEN], 1u);
            else XB_SPIN(xb_ld(&bar[XB_TOPGEN]) == tg, bar);
            __builtin_amdgcn_fence(__ATOMIC_ACQUIRE, "agent");
            xb_add(&bar[XB_XGEN(b.x)], 1u);
            asm volatile("s_waitcnt vmcnt(0)" ::: "memory");
        } else {
            XB_SPIN(xb_ld(&bar[XB_XGEN(b.x)]) == gen, bar);
            __builtin_amdgcn_fence(__ATOMIC_ACQUIRE, "agent");
            asm volatile("s_waitcnt vmcnt(0)" ::: "memory");
        }
    }
    __syncthreads();
}

struct Args { const float* in[15]; float* out; unsigned char* ws; int ph_lo, ph_hi; };
constexpr int N_PHASES = 1 + 2 * 10 + 2 * 8;

template <class Epi>
__device__ __forceinline__ void run_gemm(LAS unsigned char* lds, const bf16* A, const bf16* Bt, int N, int K, const Epi& E) {
    pg8::Gemm g{A, Bt, M, N, K}; pg8::StaticOrder S; S.init(M, N, (int)gridDim.x, (int)blockIdx.x);
    pg8::gemm_phase<Epi, pg8::StaticOrder, true, true>(lds, g, S, E);
}

__global__ void __launch_bounds__(NTHR, 2) mega_fwd(Args args) {
    extern __shared__ __attribute__((aligned(16))) unsigned char lds_raw[];
    LAS unsigned char* lds = (LAS unsigned char*)lds_raw;
    cg::grid_group grid = cg::this_grid();
    volatile LAS unsigned* bst = (volatile LAS unsigned*)(lds + LDS_BYTES - 64);
    if (threadIdx.x < 16) bst[threadIdx.x] = 0u;
    __syncthreads();
    XcdBarrier xbar = xcd_barrier_post((unsigned*)(args.ws + WS_CTL) + 4096, bst);
    const int lo = args.ph_lo, hi = args.ph_hi;
    int ph = 0;
#define PH_BEGIN if (ph >= lo && ph < hi) { \
    int tid = threadIdx.x; asm volatile("" : "+v"(tid)); \
    const int lane = tid & 63, wave = __builtin_amdgcn_readfirstlane(tid >> 6); \
    const int G = gridDim.x, gw = blockIdx.x * NWAVES + wave, NGW = G * NWAVES, gtid = blockIdx.x * NTHR + tid, NT = G * NTHR; \
    unsigned char* ws = args.ws; asm volatile("" : "+s"(ws)); \
    (void)lane; (void)gw; (void)NGW; (void)gtid; (void)NT;
#define PH_END } ++ph; if (ph - 1 >= lo && ph < hi) { if (ph == 1) grid.sync(); else xcd_barrier(xbar); }
#define x_in args.in[0]
#define hg_w_in args.in[1]
#define hg_w_out args.in[2]
#define hg_gn args.in[3]
#define hg_lb args.in[4]
#define sc_w_in args.in[5]
#define sc_w_conv args.in[6]
#define sc_w_out args.in[7]
#define ff_w_in args.in[8]
#define ff_w_conv args.in[9]
#define ff_w_out args.in[10]
#define n_pre_mix args.in[11]
#define n_post_mix args.in[12]
#define n_pre_ffn args.in[13]
#define n_post_ffn args.in[14]
#define WHGI ((bf16*)(ws + WS_WHGI))
#define WHGO ((bf16*)(ws + WS_WHGO))
#define WSCI ((bf16*)(ws + WS_WSCI))
#define WSCO ((bf16*)(ws + WS_WSCO))
#define WFI ((bf16*)(ws + WS_WFI))
#define WFO ((bf16*)(ws + WS_WFO))
#define X ((bf16*)(ws + WS_X))
#define XN ((bf16*)(ws + WS_XN))
#define MB ((bf16*)(ws + WS_MBUF))
#define U (ws + WS_U)
#define ACT ((bf16*)(ws + WS_ACT))
#define Y ((bf16*)(ws + WS_ACT))
#define Qb ((bf16*)(ws + WS_U + U_Q))
#define Vb ((bf16*)(ws + WS_U + U_V))
#define Gb ((bf16*)(ws + WS_U + U_G))
#define LFf ((float*)(ws + WS_U + U_LFF))
#define LFb ((float*)(ws + WS_U + U_LFB))
#define Of ((float*)(ws + WS_REC))
#define Ob ((float*)(ws + WS_REC + 64 * MiB))

    PH_BEGIN
        LAS float* scr = (LAS float*)(lds + wave * 16384);
        for (int j = 0; j < 2; ++j) {
            transpose_matrix(hg_w_in + (size_t)j * D * N_HG, D, N_HG, WHGI + (size_t)j * N_HG * D, scr, gw, NGW, lane);
            transpose_matrix(hg_w_out + (size_t)j * D * D, D, D, WHGO + (size_t)j * D * D, scr, gw, NGW, lane);
            transpose_matrix(sc_w_in + (size_t)j * D * N_SC, D, N_SC, WSCI + (size_t)j * N_SC * D, scr, gw, NGW, lane);
            transpose_matrix(sc_w_out + (size_t)j * D * D, D, D, WSCO + (size_t)j * D * D, scr, gw, NGW, lane);
        }
        for (int i = 0; i < DEPTH; ++i) {
            transpose_matrix(ff_w_in + (size_t)i * D * N_FI, D, N_FI, WFI + (size_t)i * N_FI * D, scr, gw, NGW, lane);
            transpose_matrix(ff_w_out + (size_t)i * FF * D, FF, D, WFO + (size_t)i * D * FF, scr, gw, NGW, lane);
        }
        rownorm_phase<true>(x_in, nullptr, nullptr, n_pre_mix, X, nullptr, XN, gw, NGW, lane);
    PH_END

    for (int i = 0; i < DEPTH; ++i) {
        const int j = i >> 1;
        if ((i & 1) == 0) {
            PH_BEGIN
                pg8::EpiHgrn E{U, hg_lb, j};
                run_gemm(lds, XN, WHGI + (size_t)j * N_HG * D, N_HG, D, E);
            PH_END
            PH_BEGIN
                rec_pass1(lds, Vb, LFf, LFb, (float*)(ws + WS_REC + REC_UT), (float*)(ws + WS_REC + REC_DEC), tid);
            PH_END
            PH_BEGIN
                rec_pass2((const float*)(ws + WS_REC + REC_UT), (const float*)(ws + WS_REC + REC_DEC), (bf16*)(ws + WS_REC + REC_ST), gtid, NT);
            PH_END
            PH_BEGIN
                rec_pass3(lds, Qb, Vb, Gb, LFf, LFb, (const bf16*)(ws + WS_REC + REC_ST), hg_gn + (size_t)j * HK, Y, tid);
            PH_END
            PH_BEGIN
                pg8::EpiBf16 E{MB, D};
                run_gemm(lds, Y, WHGO + (size_t)j * D * D, D, D, E);
            PH_END
        } else {
            PH_BEGIN
                pg8::EpiBf16 E{(bf16*)U, N_SC};
                run_gemm(lds, XN, WSCI + (size_t)j * N_SC * D, N_SC, D, E);
            PH_END
            PH_BEGIN
                sconv_phase((const bf16*)U, sc_w_conv + (size_t)j * 3 * D, Y, gtid, NT);
            PH_END
            PH_BEGIN
                pg8::EpiBf16 E{MB, D};
                run_gemm(lds, Y, WSCO + (size_t)j * D * D, D, D, E);
            PH_END
        }
        PH_BEGIN
            rownorm_phase<false>(X, MB, n_post_mix + (size_t)i * D, n_pre_ffn + (size_t)i * D, X, nullptr, XN, gw, NGW, lane);
        PH_END
        PH_BEGIN
            pg8::EpiBf16 E{(bf16*)U, N_FI};
            run_gemm(lds, XN, WFI + (size_t)i * N_FI * D, N_FI, D, E);
        PH_END
        PH_BEGIN
            ffnact_phase((const bf16*)U, ff_w_conv + (size_t)i * 3 * N_FI, ACT, gtid, NT);
        PH_END
        PH_BEGIN
            pg8::EpiBf16 E{MB, D};
            run_gemm(lds, ACT, WFO + (size_t)i * D * FF, D, FF, E);
        PH_END
        PH_BEGIN
            if (i == DEPTH - 1) rownorm_phase<false>(X, MB, n_post_ffn + (size_t)i * D, nullptr, nullptr, args.out, nullptr, gw, NGW, lane);
            else rownorm_phase<false>(X, MB, n_post_ffn + (size_t)i * D, n_pre_mix + (size_t)(i + 1) * D, X, nullptr, XN, gw, NGW, lane);
        PH_END
    }
#undef PH_BEGIN
#undef PH_END
#undef X
#undef Y
#undef U
}

#ifndef MK_MULTI
#define MK_MULTI 0
#endif
extern "C" void kernel_launch(void* const* d_in, const int* in_sizes, int n_in, void* d_out, int out_size, void* d_ws, size_t ws_size, hipStream_t stream) {
    static int grid = 0;
    if (grid == 0) {
        if (n_in != 15 || out_size != M * D || ws_size < WS_END) { fprintf(stderr, "kernel_launch: unexpected shapes (n_in %d out %d ws %zu)\n", n_in, out_size, ws_size); grid = -1; return; }
        int dev = 0, cus = 0, per_cu = 0;
        hipGetDevice(&dev); hipDeviceGetAttribute(&cus, hipDeviceAttributeMultiprocessorCount, dev);
        if (hipFuncSetAttribute((const void*)mega_fwd, hipFuncAttributeMaxDynamicSharedMemorySize, LDS_BYTES) != hipSuccess) { fprintf(stderr, "hipFuncSetAttribute failed\n"); grid = -1; return; }
        if (hipOccupancyMaxActiveBlocksPerMultiprocessor(&per_cu, (const void*)mega_fwd, NTHR, LDS_BYTES) != hipSuccess || per_cu < 1) { fprintf(stderr, "occupancy query: %d\n", per_cu); per_cu = 1; }
        (void)hipGetLastError();
        grid = cus * 1;
    }
    if (grid < 0) return;
    if (hipMemsetAsync((char*)d_ws + WS_CTL, 0, 65536, stream) != hipSuccess) { fprintf(stderr, "memset failed\n"); return; }
    Args a{};
    for (int i = 0; i < 15; ++i) a.in[i] = (const float*)d_in[i];
    a.out = (float*)d_out; a.ws = (unsigned char*)d_ws;
#if MK_MULTI
    for (int p = 0; p < N_PHASES; ++p) { a.ph_lo = p; a.ph_hi = p + 1; hipLaunchKernelGGL(mega_fwd, dim3(grid), dim3(NTHR), LDS_BYTES, stream, a); }
#else
    a.ph_lo = 0; a.ph_hi = N_PHASES;
    void* kargs[] = {&a};
    hipError_t e = hipLaunchCooperativeKernel((const void*)mega_fwd, dim3(grid), dim3(NTHR), kargs, LDS_BYTES, stream);
    if (e != hipSuccess) fprintf(stderr, "cooperative launch failed: %s (grid %d)\n", hipGetErrorString(e), grid);
#endif
}
```

```cpp
#include <hip/hip_runtime.h>
#include <hip/hip_cooperative_groups.h>
#include <cstdio>
#include <cstdint>
namespace cg = cooperative_groups;
namespace pg8 {
#define PG8_LAS __attribute__((address_space(3)))
typedef unsigned short bf16_t;
typedef short bf16x8 __attribute__((ext_vector_type(8)));
typedef float f32x4 __attribute__((ext_vector_type(4)));
typedef unsigned u32x4 __attribute__((ext_vector_type(4)));
constexpr int BM = 256, BK = 64, HALF = 128, HTB = HALF * BK * 2  , STAGE_BYTES = 8 * HTB, NXCD = 8, WGM = 8;

__host__ __device__ __forceinline__ int lds_byte(int r, int c) { const int st = (r >> 4) * 2 + (c >> 5), rr = r & 15, cc = c & 31, ob = rr * 64 + cc * 2; return st * 1024 + (ob ^ (((ob >> 9) & 1) << 5)); }
__host__ __device__ __forceinline__ void stage_rc(int b, int& R, int& C) { const int st = b / 1024, sb = b % 1024, swz = sb ^ (((sb >> 9) & 1) << 5); R = (st >> 1) * 16 + swz / 64; C = (st & 1) * 32 + (swz % 64) / 2; }
__host__ __device__ __forceinline__ int perm32(int rho) { const int n = rho >> 4, i = rho & 15; return 8 * (i >> 2) + 4 * n + (i & 3); }

struct Unit { int pm, pn; };
struct Gemm { const bf16_t* A; const bf16_t* Bt; int M, N, K; };

struct StaticOrder {
    int nM, nN, nwg, G, c;
    __host__ __device__ void init(int M, int N, int G_, int c_) { nM = M / BM; nN = N / BM; nwg = nM * nN; G = G_; c = c_; }
    __host__ __device__ bool next(int i, Unit& u) const {
        const long L = (long)i * G + c; if (L >= nwg) return false;
        int wgid = (int)L; { const int q = nwg / NXCD, r = nwg % NXCD, xcd = wgid % NXCD, off = wgid / NXCD; wgid = (xcd < r ? xcd * (q + 1) : r * (q + 1) + (xcd - r) * q) + off; }
        const int nig = WGM * nN, gid = wgid / nig, fm = gid * WGM, gsz = (nM - fm) < WGM ? (nM - fm) : WGM;
        u.pm = fm + ((wgid % nig) % gsz); u.pn = (wgid % nig) / gsz; return true;
    }
    __device__ __forceinline__ void a_ready(const Unit&) const {}
    __device__ __forceinline__ void done(const Unit&) const {}
};
__device__ __forceinline__ unsigned cvt_pk_bf16(float lo, float hi) { unsigned r; asm volatile("v_cvt_pk_bf16_f32 %0, %1, %2" : "=v"(r) : "v"(lo), "v"(hi)); return r; }
typedef float f32x2 __attribute__((ext_vector_type(2)));
template <class Epi, class Sched, bool ALIGN_EPI = false, bool SP2 = false>
__device__ __forceinline__ void gemm_phase(PG8_LAS unsigned char* lds, const Gemm g, const Sched& S, const Epi& E, int tid_in) {
    int tid_o = tid_in; asm volatile("" : "+v"(tid_o));
    const int tid = tid_o, wid = __builtin_amdgcn_readfirstlane(tid >> 6), lane = tid & 63, wr = wid >> 2, wc = wid & 3, fr = lane & 15, fq = lane >> 4;
    const int K = g.K, nt = K / BK;
    unsigned voffA[2], voffB[2];
#pragma unroll
    for (int i = 0; i < 2; ++i) { int R, C; stage_rc(tid * 16 + i * 8192, R, C); const int Rb = Epi::PERM ? ((R & ~31) + perm32(R & 31)) : R;
        voffA[i] = (unsigned)(R * K + C) * 2u; voffB[i] = (unsigned)(Rb * K + C) * 2u; }
    const size_t kstep = (size_t)(BK * 2);
    const size_t hstep = (size_t)HALF * K * 2;
    const size_t tstep = 2 * hstep;
    const unsigned ldsw = (unsigned)wid * 1024u;
    const int aoff = lds_byte(wr * 64 + fr, fq * 8), boff = lds_byte(wc * 32 + fr, fq * 8);
#define PG8_SA(b, h) (((b) * 2 + (h)) * HTB)
#define PG8_SB(b, h) ((4 + (b) * 2 + (h)) * HTB)
#define PG8_STAGE(bufoff, gbase, voff) do { _Pragma("unroll") for (int _i = 0; _i < 2; ++_i) \
        __builtin_amdgcn_global_load_lds((const unsigned*)((const char*)(gbase) + (voff)[_i]), (PG8_LAS unsigned*)(lds + (bufoff) + ldsw + _i * 8192), 16, 0, 0); } while (0)
#define PG8_LDA(dst, b, h) do { _Pragma("unroll") for (int m = 0; m < 4; ++m) _Pragma("unroll") for (int k = 0; k < 2; ++k) dst[m][k] = *(const PG8_LAS bf16x8*)(lds + PG8_SA(b, h) + aoff + m * 2048 + k * 1024); } while (0)
#define PG8_LDB(dst, b, h) do { _Pragma("unroll") for (int n = 0; n < 2; ++n) _Pragma("unroll") for (int k = 0; k < 2; ++k) dst[n][k] = *(const PG8_LAS bf16x8*)(lds + PG8_SB(b, h) + boff + n * 2048 + k * 1024); } while (0)
#define PG8_MMA(ai, bj, At, Bt) do { __builtin_amdgcn_s_setprio(1); _Pragma("unroll") for (int m = 0; m < 4; ++m) _Pragma("unroll") for (int n = 0; n < 2; ++n) _Pragma("unroll") for (int k = 0; k < 2; ++k) \
        acc[ai][bj][m][n] = __builtin_amdgcn_mfma_f32_16x16x32_bf16(Bt[n][k], At[m][k], acc[ai][bj][m][n], 0, 0, 0); __builtin_amdgcn_s_setprio(0); } while (0)
#define PG8_WAIT_V(n) asm volatile("s_waitcnt vmcnt(" #n ")" ::: "memory")
#define PG8_WAIT_L(n) asm volatile("s_waitcnt lgkmcnt(" #n ")" ::: "memory")
#define PG8_BAR __builtin_amdgcn_s_barrier()
#define PG8_SCHED __builtin_amdgcn_sched_barrier(0)
    Unit cur, nxt; int ui = 0;
    if (!S.next(0, cur)) return;
    f32x4 acc[2][2][4][2];
#pragma unroll
    for (int a = 0; a < 2; ++a)
#pragma unroll
        for (int b = 0; b < 2; ++b)
#pragma unroll
            for (int m = 0; m < 4; ++m)
#pragma unroll
                for (int n = 0; n < 2; ++n) acc[a][b][m][n] = (f32x4){0.f, 0.f, 0.f, 0.f};
    bf16x8 At[4][2], B0[2][2], B1[2][2];
    const char* cA = (const char*)g.A + (size_t)cur.pm * tstep; const char* cB = (const char*)g.Bt + (size_t)cur.pn * tstep;
    S.a_ready(cur);
    if constexpr (SP2) {
        PG8_STAGE(PG8_SB(0, 0), cB, voffB); PG8_STAGE(PG8_SB(0, 1), cB + hstep, voffB); PG8_STAGE(PG8_SA(0, 0), cA, voffA); PG8_STAGE(PG8_SA(0, 1), cA + hstep, voffA);
        if (wr == 1) PG8_BAR;
        PG8_WAIT_V(2); PG8_BAR;
        PG8_STAGE(PG8_SB(1, 0), cB + kstep, voffB); PG8_STAGE(PG8_SA(1, 0), cA + kstep, voffA); PG8_STAGE(PG8_SB(1, 1), cB + hstep + kstep, voffB);
        PG8_WAIT_V(6); PG8_BAR;
    } else {
        PG8_STAGE(PG8_SB(0, 0), cB, voffB); PG8_STAGE(PG8_SA(0, 0), cA, voffA); PG8_STAGE(PG8_SB(0, 1), cB + hstep, voffB); PG8_STAGE(PG8_SA(0, 1), cA + hstep, voffA);
        if (wr == 1) PG8_BAR;
        PG8_WAIT_V(4); PG8_BAR;
        PG8_STAGE(PG8_SB(1, 0), cB + kstep, voffB); PG8_STAGE(PG8_SA(1, 0), cA + kstep, voffA); PG8_STAGE(PG8_SB(1, 1), cB + hstep + kstep, voffB);
        PG8_WAIT_V(6); PG8_BAR;
    }
    for (;;) {
        const bool has_next = S.next(ui + 1, nxt);
        const char* nA = has_next ? (const char*)g.A + (size_t)nxt.pm * tstep : cA; const char* nB = has_next ? (const char*)g.Bt + (size_t)nxt.pn * tstep : cB;
        for (int t = 0; t < nt; t += 2) {
            const bool last = (t == nt - 2);
            const char* a1 = cA + (size_t)(t + 1) * kstep;
            const char* a2 = last ? nA : cA + (size_t)(t + 2) * kstep; const char* b2 = last ? nB : cB + (size_t)(t + 2) * kstep;
            const char* a3 = a2 + kstep; const char* b3 = b2 + kstep;
            if (last && has_next) S.a_ready(nxt);
            if constexpr (SP2) {
            PG8_LDB(B0, 0, 0); PG8_LDB(B1, 0, 1); PG8_SCHED; PG8_LDA(At, 0, 0); PG8_STAGE(PG8_SA(1, 1), a1 + hstep, voffA);
            PG8_WAIT_V(8); PG8_WAIT_L(0); PG8_BAR; PG8_MMA(0, 0, At, B0); PG8_MMA(0, 1, At, B1); PG8_BAR; PG8_SCHED;
            PG8_LDA(At, 0, 1); PG8_STAGE(PG8_SB(0, 0), b2, voffB); PG8_STAGE(PG8_SB(0, 1), b2 + hstep, voffB); PG8_STAGE(PG8_SA(0, 0), a2, voffA);
            PG8_WAIT_V(8); PG8_WAIT_L(0); PG8_BAR; PG8_MMA(1, 0, At, B0); PG8_MMA(1, 1, At, B1); PG8_BAR; PG8_SCHED;
            PG8_LDB(B0, 1, 0); PG8_LDB(B1, 1, 1); PG8_SCHED; PG8_LDA(At, 1, 0); PG8_STAGE(PG8_SA(0, 1), a2 + hstep, voffA);
            PG8_WAIT_V(8); PG8_WAIT_L(0); PG8_BAR; PG8_MMA(0, 0, At, B0); PG8_MMA(0, 1, At, B1); PG8_BAR; PG8_SCHED;
            PG8_LDA(At, 1, 1); PG8_STAGE(PG8_SB(1, 0), b3, voffB); PG8_STAGE(PG8_SB(1, 1), b3 + hstep, voffB); PG8_STAGE(PG8_SA(1, 0), a3, voffA);
            PG8_WAIT_V(8); PG8_WAIT_L(0); PG8_BAR; PG8_MMA(1, 0, At, B0); PG8_MMA(1, 1, At, B1); PG8_BAR; PG8_SCHED;
            } else {
            PG8_LDB(B0, 0, 0); PG8_SCHED; PG8_LDA(At, 0, 0); PG8_STAGE(PG8_SA(1, 1), a1 + hstep, voffA);
            PG8_WAIT_L(8); PG8_BAR; PG8_WAIT_L(0); PG8_MMA(0, 0, At, B0); PG8_BAR; PG8_SCHED;
            PG8_LDB(B1, 0, 1); PG8_STAGE(PG8_SB(0, 0), b2, voffB);
            PG8_BAR; PG8_WAIT_L(0); PG8_MMA(0, 1, At, B1); PG8_BAR;
            PG8_LDA(At, 0, 1); PG8_STAGE(PG8_SA(0, 0), a2, voffA);
            PG8_BAR; PG8_WAIT_L(0); PG8_MMA(1, 0, At, B0); PG8_BAR; PG8_SCHED;
            PG8_STAGE(PG8_SB(0, 1), b2 + hstep, voffB);
            PG8_WAIT_V(6); PG8_BAR; PG8_MMA(1, 1, At, B1); PG8_BAR;
            PG8_LDB(B0, 1, 0); PG8_SCHED; PG8_LDA(At, 1, 0); PG8_STAGE(PG8_SA(0, 1), a2 + hstep, voffA);
            PG8_WAIT_L(8); PG8_BAR; PG8_WAIT_L(0); PG8_MMA(0, 0, At, B0); PG8_BAR; PG8_SCHED;
            PG8_LDB(B1, 1, 1); PG8_STAGE(PG8_SB(1, 0), b3, voffB);
            PG8_BAR; PG8_WAIT_L(0); PG8_MMA(0, 1, At, B1); PG8_BAR;
            PG8_LDA(At, 1, 1); PG8_STAGE(PG8_SA(1, 0), a3, voffA);
            PG8_BAR; PG8_WAIT_L(0); PG8_MMA(1, 0, At, B0); PG8_BAR; PG8_SCHED;
            PG8_STAGE(PG8_SB(1, 1), b3 + hstep, voffB);
            PG8_WAIT_V(6); PG8_BAR; PG8_MMA(1, 1, At, B1); PG8_BAR;
            }
        }
        if constexpr (ALIGN_EPI) { if (wr == 0) PG8_BAR; }
        if constexpr (!Epi::AFTER_DRAIN) { E(acc, cur, wr, wc, fr, fq); S.done(cur); }
        if (!has_next) break;
#pragma unroll
        for (int a = 0; a < 2; ++a)
#pragma unroll
            for (int b = 0; b < 2; ++b)
#pragma unroll
                for (int m = 0; m < 4; ++m)
#pragma unroll
                    for (int n = 0; n < 2; ++n) acc[a][b][m][n] = (f32x4){0.f, 0.f, 0.f, 0.f};
        cur = nxt; cA = nA; cB = nB; ++ui;
        if constexpr (ALIGN_EPI) { if (wr == 1) PG8_BAR; }
    }
    PG8_WAIT_V(0);
    if constexpr (!ALIGN_EPI) { if (wr == 0) PG8_BAR; }
    PG8_BAR;
    if constexpr (Epi::AFTER_DRAIN) { E.fused(acc, cur, wr, wc, fr, fq, lds, wid, lane); S.done(cur); }
#undef PG8_SA
#undef PG8_SB
#undef PG8_STAGE
#undef PG8_LDA
#undef PG8_LDB
#undef PG8_MMA
#undef PG8_WAIT_V
#undef PG8_WAIT_L
#undef PG8_BAR
#undef PG8_SCHED
}
}
namespace pg8 {
__device__ __forceinline__ float fsigmoid(float x) { return __builtin_amdgcn_rcpf(1.0f + __expf(-x)); }
struct EpiF32 {
    static constexpr bool PERM = false, AFTER_DRAIN = false;
    float* C; int ldc;
    __device__ __forceinline__ void operator()(const f32x4 (&acc)[2][2][4][2], const Unit& u, int wr, int wc, int fr, int fq) const {
        const int row0 = u.pm * BM + wr * 64 + fr, col0 = u.pn * BM + wc * 32 + 4 * fq;
#pragma unroll
        for (int ai = 0; ai < 2; ++ai)
#pragma unroll
            for (int m = 0; m < 4; ++m) { float* rowp = C + (size_t)(row0 + ai * HALF + m * 16) * ldc + col0;
#pragma unroll
                for (int bj = 0; bj < 2; ++bj)
#pragma unroll
                    for (int n = 0; n < 2; ++n) *(f32x4*)(rowp + bj * HALF + n * 16) = acc[ai][bj][m][n]; }
    }
};
struct EpiBf16 {
    static constexpr bool PERM = true, AFTER_DRAIN = false;
    bf16_t* O; int ldc;
    __device__ __forceinline__ void operator()(const f32x4 (&acc)[2][2][4][2], const Unit& u, int wr, int wc, int fr, int fq) const {
        const int row0 = u.pm * BM + wr * 64 + fr, col0 = u.pn * BM + wc * 32 + 8 * fq;
#pragma unroll
        for (int ai = 0; ai < 2; ++ai)
#pragma unroll
            for (int m = 0; m < 4; ++m) { bf16_t* rowp = O + (size_t)(row0 + ai * HALF + m * 16) * ldc + col0;
#pragma unroll
                for (int bj = 0; bj < 2; ++bj) { const f32x4 v0 = acc[ai][bj][m][0], v1 = acc[ai][bj][m][1];
                    u32x4 w; w.x = cvt_pk_bf16(v0[0], v0[1]); w.y = cvt_pk_bf16(v0[2], v0[3]); w.z = cvt_pk_bf16(v1[0], v1[1]); w.w = cvt_pk_bf16(v1[2], v1[3]);
                    *(u32x4*)(rowp + bj * HALF) = w; } }
    }
};
struct EpiHgrn {
    static constexpr bool PERM = true, AFTER_DRAIN = false;
    unsigned char* Ub; const float* lbs; int layer_j;
    __device__ __forceinline__ void operator()(const f32x4 (&acc)[2][2][4][2], const Unit& u, int wr, int wc, int fr, int fq) const {
        const int seg = u.pn >> 3, colt = (u.pn & 7) * BM;
        const int row0 = u.pm * BM + wr * 64 + fr, col0 = colt + wc * 32 + 8 * fq;
        if (seg == 1 || seg == 2) {
            const int dir = seg - 1; float* LF = (float*)(Ub + ((size_t)(96 + 64 * dir) << 20));
#pragma unroll
            for (int bj = 0; bj < 2; ++bj) {
                float lb[8];
#pragma unroll
                for (int e = 0; e < 8; ++e) lb[e] = 0.f;
                if (layer_j == 1) {
                    const f32x4 a0 = *(const f32x4*)(lbs + (size_t)(dir * 2 + 0) * 2048 + col0 + bj * HALF), a1 = *(const f32x4*)(lbs + (size_t)(dir * 2 + 0) * 2048 + col0 + bj * HALF + 4);
                    const f32x4 b0 = *(const f32x4*)(lbs + (size_t)(dir * 2 + 1) * 2048 + col0 + bj * HALF), b1 = *(const f32x4*)(lbs + (size_t)(dir * 2 + 1) * 2048 + col0 + bj * HALF + 4);
#pragma unroll
                    for (int e = 0; e < 4; ++e) { lb[e] = fsigmoid(b0[e] - a0[e]); lb[4 + e] = fsigmoid(b1[e] - a1[e]); }
                }
#pragma unroll
                for (int ai = 0; ai < 2; ++ai)
#pragma unroll
                    for (int m = 0; m < 4; ++m) { float* rowp = LF + (size_t)(row0 + ai * HALF + m * 16) * 2048 + col0 + bj * HALF;
#pragma unroll
                        for (int n = 0; n < 2; ++n) { f32x4 o;
#pragma unroll
                            for (int e = 0; e < 4; ++e) { const float s = fsigmoid(acc[ai][bj][m][n][e]); const float l = lb[4 * n + e]; o[e] = __logf(l + (1.0f - l) * s); }
                            *(f32x4*)(rowp + 4 * n) = o; } }
            }
        } else {
            const int sel = (seg == 0) ? 0 : ((seg == 3) ? 1 : 2); bf16_t* O = (bf16_t*)(Ub + ((size_t)(32 * sel) << 20)); const bool act = (seg != 3);
#pragma unroll
            for (int ai = 0; ai < 2; ++ai)
#pragma unroll
                for (int m = 0; m < 4; ++m) { bf16_t* rowp = O + (size_t)(row0 + ai * HALF + m * 16) * 2048 + col0;
#pragma unroll
                    for (int bj = 0; bj < 2; ++bj) { f32x4 v0 = acc[ai][bj][m][0], v1 = acc[ai][bj][m][1];
                        if (act) {
#pragma unroll
                            for (int e = 0; e < 4; ++e) { v0[e] = v0[e] * fsigmoid(v0[e]); v1[e] = v1[e] * fsigmoid(v1[e]); } }
                        u32x4 w; w.x = cvt_pk_bf16(v0[0], v0[1]); w.y = cvt_pk_bf16(v0[2], v0[3]); w.z = cvt_pk_bf16(v1[0], v1[1]); w.w = cvt_pk_bf16(v1[2], v1[3]);
                        *(u32x4*)(rowp + bj * HALF) = w; } }
        }
    }
};
}
#define GAS __attribute__((address_space(1)))
#define LAS __attribute__((address_space(3)))
typedef unsigned short bf16;
typedef unsigned v4u __attribute__((ext_vector_type(4)));
typedef unsigned v2u __attribute__((ext_vector_type(2)));
typedef float f32x4 __attribute__((ext_vector_type(4)));
typedef short bf16x8 __attribute__((ext_vector_type(8)));
constexpr int NWAVES = 8, NTHR = 512;
constexpr int D = 2048, BATCH = 2, SEQ = 4096, M = BATCH * SEQ, DEPTH = 4, NH = 16, HK = 128, FF = 5632;
constexpr int N_HG = 5 * D, N_SC = 3 * D, N_FI = 2 * FF;
constexpr float EPS = 1e-6f;
constexpr size_t MiB = 1u << 20;
constexpr size_t WS_CTL = 0, WS_WHGI = 2 * MiB, WS_WHGO = 82 * MiB, WS_WSCI = 98 * MiB, WS_WSCO = 146 * MiB, WS_WFI = 162 * MiB, WS_WFO = 338 * MiB;
constexpr size_t WS_X = 426 * MiB, WS_XN = 490 * MiB, WS_MBUF = 522 * MiB, WS_U = 586 * MiB, WS_ACT = 810 * MiB, WS_REC = 898 * MiB, WS_END = 1286 * MiB;
constexpr size_t U_Q = 0, U_V = 32 * MiB, U_G = 64 * MiB, U_LFF = 96 * MiB, U_LFB = 160 * MiB;
constexpr int LDS_BYTES = 147456;

__device__ __forceinline__ unsigned f2bf(float f) { unsigned u = __builtin_bit_cast(unsigned, f); return (u + 0x7fffu + ((u >> 16) & 1u)) >> 16; }
__device__ __forceinline__ unsigned pk2(float lo, float hi) { return f2bf(lo) | (f2bf(hi) << 16); }
__device__ __forceinline__ float bflo(unsigned w) { return __builtin_bit_cast(float, w << 16); }
__device__ __forceinline__ float bfhi(unsigned w) { return __builtin_bit_cast(float, w & 0xffff0000u); }
__device__ __forceinline__ float bf2f(bf16 b) { return __builtin_bit_cast(float, ((unsigned)b) << 16); }
__device__ __forceinline__ float shx(float v, int o, int lane) { return __builtin_bit_cast(float, __builtin_amdgcn_ds_bpermute((lane ^ o) << 2, __builtin_bit_cast(int, v))); }
__device__ __forceinline__ float wave_sum(float v, int lane) {
#pragma unroll
    for (int o = 1; o < 64; o <<= 1) v += shx(v, o, lane);
    return v;
}
__device__ __forceinline__ float fsig(float x) { return __builtin_amdgcn_rcpf(1.0f + __expf(-x)); }
#define LDS_WAIT() asm volatile("s_waitcnt lgkmcnt(0)" ::: "memory")

__device__ __forceinline__ void p0_transpose_item(const float* W, int K, int N, bf16* WT, LAS float* scr, int item, int lane) {
    const int nblk = N / 32, kb = item / nblk, nb = item % nblk, k0 = 64 * kb, n0 = 32 * nb;
#pragma unroll 8
    for (int i = 0; i < 32; ++i) { const int kk = 2 * i + (lane >> 5); scr[kk * 33 + (lane & 31)] = W[(size_t)(k0 + kk) * N + n0 + (lane & 31)]; }
    LDS_WAIT(); asm volatile("" ::: "memory");
    const int c = lane & 7;
#pragma unroll
    for (int j = 0; j < 4; ++j) { const int n = (lane >> 3) + 8 * j; const LAS float* s = scr + (8 * c) * 33 + n;
        v4u o; o.x = pk2(s[0 * 33], s[1 * 33]); o.y = pk2(s[2 * 33], s[3 * 33]); o.z = pk2(s[4 * 33], s[5 * 33]); o.w = pk2(s[6 * 33], s[7 * 33]);
        *(v4u*)(WT + (size_t)(n0 + n) * K + k0 + 8 * c) = o; }
    LDS_WAIT(); asm volatile("" ::: "memory");
}
__device__ __forceinline__ void transpose_matrix(const float* W, int K, int N, bf16* WT, LAS float* scr, int gw, int NGW, int lane) {
    const int items = (K / 64) * (N / 32);
    for (int it = gw; it < items; it += NGW) p0_transpose_item(W, K, N, WT, scr, it, lane);
}

__device__ __forceinline__ void unpack8(const v4u a, float (&f)[8]) { f[0] = bflo(a.x); f[1] = bfhi(a.x); f[2] = bflo(a.y); f[3] = bfhi(a.y); f[4] = bflo(a.z); f[5] = bfhi(a.z); f[6] = bflo(a.w); f[7] = bfhi(a.w); }
__device__ __forceinline__ v4u pack8(const float (&f)[8]) { v4u o; o.x = pk2(f[0], f[1]); o.y = pk2(f[2], f[3]); o.z = pk2(f[4], f[5]); o.w = pk2(f[6], f[7]); return o; }

template <bool XF32>
__device__ __forceinline__ void rownorm_phase(const void* xin, const bf16* mb, const float* w_post, const float* w_next, bf16* xout, float* fout, bf16* xn, int gw, int NGW, int lane) {
    for (int m = gw; m < M; m += NGW) {
        float x[4][8];
#pragma unroll
        for (int j = 0; j < 4; ++j) {
            if (XF32) { const f32x4* xr = (const f32x4*)((const float*)xin + (size_t)m * D + 8 * lane + 512 * j); const f32x4 a = xr[0], b = xr[1];
                x[j][0] = a.x; x[j][1] = a.y; x[j][2] = a.z; x[j][3] = a.w; x[j][4] = b.x; x[j][5] = b.y; x[j][6] = b.z; x[j][7] = b.w; }
            else unpack8(*(const v4u*)((const bf16*)xin + (size_t)m * D + 8 * lane + 512 * j), x[j]);
        }
        if (mb) {
            float mm[4][8]; float ss = 0.f;
#pragma unroll
            for (int j = 0; j < 4; ++j) { unpack8(*(const v4u*)(mb + (size_t)m * D + 8 * lane + 512 * j), mm[j]);
#pragma unroll
                for (int e = 0; e < 8; ++e) ss += mm[j][e] * mm[j][e]; }
            const float rstd = __builtin_amdgcn_rsqf(wave_sum(ss, lane) * (1.f / D) + EPS);
#pragma unroll
            for (int j = 0; j < 4; ++j) { const f32x4 w0 = *(const f32x4*)(w_post + 8 * lane + 512 * j), w1 = *(const f32x4*)(w_post + 8 * lane + 512 * j + 4);
                x[j][0] += mm[j][0] * rstd * w0.x; x[j][1] += mm[j][1] * rstd * w0.y; x[j][2] += mm[j][2] * rstd * w0.z; x[j][3] += mm[j][3] * rstd * w0.w;
                x[j][4] += mm[j][4] * rstd * w1.x; x[j][5] += mm[j][5] * rstd * w1.y; x[j][6] += mm[j][6] * rstd * w1.z; x[j][7] += mm[j][7] * rstd * w1.w; }
        }
        if (xout) {
#pragma unroll
            for (int j = 0; j < 4; ++j) *(v4u*)(xout + (size_t)m * D + 8 * lane + 512 * j) = pack8(x[j]); }
        if (fout) {
#pragma unroll
            for (int j = 0; j < 4; ++j) { f32x4* o = (f32x4*)(fout + (size_t)m * D + 8 * lane + 512 * j); o[0] = (f32x4){x[j][0], x[j][1], x[j][2], x[j][3]}; o[1] = (f32x4){x[j][4], x[j][5], x[j][6], x[j][7]}; } }
        if (xn) {
            float s2 = 0.f;
#pragma unroll
            for (int j = 0; j < 4; ++j)
#pragma unroll
                for (int e = 0; e < 8; ++e) s2 += x[j][e] * x[j][e];
            const float r2 = __builtin_amdgcn_rsqf(wave_sum(s2, lane) * (1.f / D) + EPS);
#pragma unroll
            for (int j = 0; j < 4; ++j) { const f32x4 w0 = *(const f32x4*)(w_next + 8 * lane + 512 * j), w1 = *(const f32x4*)(w_next + 8 * lane + 512 * j + 4);
                float y[8] = {x[j][0] * r2 * w0.x, x[j][1] * r2 * w0.y, x[j][2] * r2 * w0.z, x[j][3] * r2 * w0.w, x[j][4] * r2 * w1.x, x[j][5] * r2 * w1.y, x[j][6] * r2 * w1.z, x[j][7] * r2 * w1.w};
                *(v4u*)(xn + (size_t)m * D + 8 * lane + 512 * j) = pack8(y); }
        }
    }
}

typedef pg8::bf16x8 bfx8;
#define MFMA16(a, b, c) __builtin_amdgcn_mfma_f32_16x16x32_bf16(a, b, c, 0, 0, 0)
constexpr int QS = 136, TS = 72;
constexpr int OSS = 132;
constexpr int L_QD = 0, L_QH = 64 * QS * 2, L_KH = 2 * 64 * QS * 2, L_VT = 3 * 64 * QS * 2, L_AM = L_VT + 128 * TS * 2, L_OS = L_AM + 64 * TS * 2, L_TOT = L_OS + 64 * OSS * 4, L_RECEND = L_TOT + 2048;
static_assert(L_RECEND <= 131072, "LDS map of the recurrence passes");
constexpr size_t REC_PEND = 0, REC_AEND = 16 * MiB, REC_SQ = 32 * MiB, REC_PT = 256 * MiB, REC_ALOG = 384 * MiB;
constexpr int L_QD2 = L_RECEND;
static_assert(L_QD2 + 64 * QS * 2 <= LDS_BYTES - 64, "LDS map");

__device__ __forceinline__ void load_lf(const float* LFbase, int t0, int dir, int k, int ig, float (&lf)[16]) {
#pragma unroll
    for (int j = 0; j < 16; ++j) { const int i = 16 * ig + j; const int t = dir ? (t0 + 63 - i) : (t0 + i); lf[j] = LFbase[(unsigned)(t * D + k)]; }
}
__device__ __forceinline__ void cumsum_chunk(const float (&lf)[16], int k, int ig, LAS float* TOT, float (&bb)[16], float& blast, float& r31) {
    float run = 0.f;
#pragma unroll
    for (int j = 0; j < 16; ++j) { run += lf[j]; bb[j] = run; }
    TOT[ig * 128 + k] = run;
    __syncthreads();
    const float s0 = TOT[k], s1 = TOT[128 + k], s2 = TOT[256 + k], s3 = TOT[384 + k];
    const float base = (ig > 0 ? s0 : 0.f) + (ig > 1 ? s1 : 0.f) + (ig > 2 ? s2 : 0.f);
#pragma unroll
    for (int j = 0; j < 16; ++j) bb[j] += base;
    blast = (s0 + s1) + (s2 + s3); r31 = s0 + s1;
}
__device__ __forceinline__ void gather_col(const bf16* base, int t0, int dir, int col, int ig, unsigned (&w)[8]) {
#pragma unroll
    for (int j = 0; j < 8; ++j) { const int i = 16 * ig + 2 * j; const int ta = dir ? (t0 + 63 - i) : (t0 + i), tb = dir ? (ta - 1) : (ta + 1);
        w[j] = (unsigned)base[(unsigned)(ta * D + col)] | ((unsigned)base[(unsigned)(tb * D + col)] << 16); }
}
__device__ __forceinline__ void store_colT(const unsigned (&w)[8], int col, int ig, LAS bf16* T) {
    LAS v4u* o = (LAS v4u*)(T + col * TS + 16 * ig);
    v4u o0, o1; o0.x = w[0]; o0.y = w[1]; o0.z = w[2]; o0.w = w[3]; o1.x = w[4]; o1.y = w[5]; o1.z = w[6]; o1.w = w[7];
    o[0] = o0; o[1] = o1;
}
__device__ __forceinline__ void rec_pass1(LAS unsigned char* lds, const bf16* V, const float* LFf, const float* LFb, bf16* PT, float* ALOG, float* PEND, float* AEND, int tid) {
    const int lane = tid & 63, wave = __builtin_amdgcn_readfirstlane(tid >> 6), k = tid & 127, ig = tid >> 7, fr = lane & 15, fq = lane >> 4;
    LAS bf16* KT = (LAS bf16*)(lds + L_QD); LAS bf16* VT = (LAS bf16*)(lds + L_VT); LAS float* TOT = (LAS float*)(lds + L_TOT); LAS float* DL = (LAS float*)(lds + L_OS);
    for (int item = blockIdx.x; item < 256; item += gridDim.x) {
        const int seq = item >> 2, qd = item & 3, h = seq & 15, b = (seq >> 4) & 1, dir = seq >> 5;
        const float* LFbase = (dir ? LFb : LFf) + (size_t)b * SEQ * D + h * HK;
        const bf16* Vbase = V + (size_t)b * SEQ * D + h * HK;
        f32x4 acc[8];
#pragma unroll
        for (int n = 0; n < 8; ++n) acc[n] = (f32x4){0.f, 0.f, 0.f, 0.f};
        float acum = 0.f;
        float lf[16]; unsigned vw[8];
        { const int c0 = 16 * qd; const int t0 = 64 * (dir ? 63 - c0 : c0); load_lf(LFbase, t0, dir, k, ig, lf); gather_col(Vbase, t0, dir, k, ig, vw); }
#pragma unroll 1
        for (int cc = 0; cc < 16; ++cc) {
            const int c = 16 * qd + cc, task = seq * 64 + c;
            float bb[16], blast, r31;
            cumsum_chunk(lf, k, ig, TOT, bb, blast, r31);
            unsigned w[8];
#pragma unroll
            for (int j = 0; j < 8; ++j) { const float k0 = (1.0f - __expf(lf[2 * j])) * __expf(blast - bb[2 * j]), k1 = (1.0f - __expf(lf[2 * j + 1])) * __expf(blast - bb[2 * j + 1]); w[j] = pk2(k0, k1); }
            store_colT(w, k, ig, KT);
            store_colT(vw, k, ig, VT);
            if (ig == 0) { DL[k] = __expf(blast); ALOG[(size_t)task * 128 + k] = acum; }
            acum += blast;
            {
                bf16* o = PT + (size_t)task * 16384 + (16 * wave + fr) * 128 + 4 * fq;
#pragma unroll
                for (int n = 0; n < 8; ++n) { v2u pk; pk.x = pk2(acc[n].x, acc[n].y); pk.y = pk2(acc[n].z, acc[n].w); *(v2u*)(o + 16 * n) = pk; }
            }
            if (cc < 15) { const int cn = c + 1; const int t0n = 64 * (dir ? 63 - cn : cn); load_lf(LFbase, t0n, dir, k, ig, lf); gather_col(Vbase, t0n, dir, k, ig, vw); }
            __syncthreads();
#pragma unroll
            for (int n = 0; n < 8; ++n) { const f32x4 d4 = *(const LAS f32x4*)(DL + 16 * n + 4 * fq); acc[n] = acc[n] * d4; }
#pragma unroll
            for (int ks = 0; ks < 2; ++ks) {
                const bfx8 a = *(const LAS bfx8*)(VT + (16 * wave + fr) * TS + 32 * ks + 8 * fq);
#pragma unroll
                for (int n = 0; n < 8; ++n) { const bfx8 bt = *(const LAS bfx8*)(KT + (16 * n + fr) * TS + 32 * ks + 8 * fq); acc[n] = MFMA16(bt, a, acc[n]); }
            }
            __syncthreads();
        }
        float* o = PEND + (size_t)item * 16384 + (16 * wave + fr) * 128 + 4 * fq;
#pragma unroll
        for (int n = 0; n < 8; ++n) *(f32x4*)(o + 16 * n) = acc[n];
        if (ig == 0) AEND[(size_t)item * 128 + k] = acum;
    }
}
__device__ __forceinline__ void rec_pass2(const float* PEND, const float* AEND, bf16* SQ, int gtid, int NT) {
    for (int item = gtid; item < 64 * 4096; item += NT) {
        const int seq = item >> 12, e4 = (item & 4095) * 4, k4 = e4 & 127;
        f32x4 s = (f32x4){0.f, 0.f, 0.f, 0.f};
#pragma unroll
        for (int q = 1; q < 4; ++q) {
            const f32x4 p = *(const f32x4*)(PEND + (size_t)(seq * 4 + q - 1) * 16384 + e4); const f32x4 a = *(const f32x4*)(AEND + (size_t)(seq * 4 + q - 1) * 128 + k4);
            s.x = __expf(a.x) * s.x + p.x; s.y = __expf(a.y) * s.y + p.y; s.z = __expf(a.z) * s.z + p.z; s.w = __expf(a.w) * s.w + p.w;
            v2u o; o.x = pk2(s.x, s.y); o.y = pk2(s.z, s.w); *(v2u*)(SQ + (size_t)(seq * 4 + q) * 16384 + e4) = o;
        }
    }
}
__device__ __forceinline__ void rec_pass3(LAS unsigned char* lds, const bf16* Q, const bf16* V, const bf16* Gt, const float* LFf, const float* LFb, const bf16* ST, const float* ALOG, const bf16* SQ, const float* gnw, bf16* Yo, int tid) {
    const int lane = tid & 63, wave = __builtin_amdgcn_readfirstlane(tid >> 6), k = tid & 127, ig = tid >> 7, fr = lane & 15, fq = lane >> 4;
    LAS bf16* QDl = (LAS bf16*)(lds + L_QD); LAS bf16* QHl = (LAS bf16*)(lds + L_QH); LAS bf16* KHl = (LAS bf16*)(lds + L_KH); LAS bf16* VT = (LAS bf16*)(lds + L_VT);
    LAS bf16* AM = (LAS bf16*)(lds + L_AM); LAS float* OS = (LAS float*)(lds + L_OS); LAS float* TOT = (LAS float*)(lds + L_TOT); LAS bf16* QD2 = (LAS bf16*)(lds + L_QD2);
    for (int task = blockIdx.x; task < 2048; task += gridDim.x) {
        const int C = task & 63, h = (task >> 6) & 15, b = task >> 10, t0 = 64 * C;
        const size_t goff = (size_t)(b * SEQ + t0 + (tid >> 3)) * D + h * HK + 16 * (tid & 7);
        const v4u gq0 = *(const v4u*)(Gt + goff), gq1 = *(const v4u*)(Gt + goff + 8);
#pragma unroll 1
        for (int dir = 0; dir < 2; ++dir) {
            const int c = dir ? 63 - C : C, seq = (dir * 2 + b) * 16 + h;
            const float* LFbase = (dir ? LFb : LFf) + (size_t)b * SEQ * D + h * HK;
            float lf[16], bb[16], blast, r31;
            const int rh_b = wave & 1, vq_b = wave >> 1;
            const bf16* STt = ST + ((size_t)seq * 64 + c) * 16384;
            bfx8 stf[4][2];
#pragma unroll
            for (int ks = 0; ks < 4; ++ks)
#pragma unroll
                for (int n = 0; n < 2; ++n) stf[ks][n] = *(const bfx8*)(STt + (unsigned)((32 * vq_b + 16 * n + fr) * 128 + 32 * ks + 8 * fq));
            const bf16* Qbase = Q + (size_t)b * SEQ * D + h * HK;
            unsigned qw[16];
#pragma unroll
            for (int j = 0; j < 16; ++j) { const int i = 16 * ig + j; const int t = dir ? (t0 + 63 - i) : (t0 + i); qw[j] = Qbase[(unsigned)(t * D + k)]; }
            unsigned vw[8]; gather_col(V + (size_t)b * SEQ * D + h * HK, t0, dir, k, ig, vw);
            const int qd = c >> 4;
            const float alog = ALOG[(size_t)(seq * 64 + c) * 128 + k];
            load_lf(LFbase, t0, dir, k, ig, lf);
            cumsum_chunk(lf, k, ig, TOT, bb, blast, r31);
            const float ea = qd ? __expf(alog) : 0.f;
#pragma unroll
            for (int j = 0; j < 16; ++j) { const int i = 16 * ig + j;
                const float qv = bf2f((bf16)qw[j]);
                const float eb = __expf(bb[j]), e1 = __expf(bb[j] - r31), e2 = __expf(r31 - bb[j]), kk = 1.0f - __expf(lf[j]);
                QDl[i * QS + k] = (bf16)f2bf(qv * eb); QD2[i * QS + k] = (bf16)f2bf(qv * eb * ea); QHl[i * QS + k] = (bf16)f2bf(qv * e1); KHl[i * QS + k] = (bf16)f2bf(kk * e2); }
            store_colT(vw, k, ig, VT);
            __syncthreads();
            bfx8 sqf[4][2];
            if (qd) { const bf16* SQt = SQ + (size_t)(seq * 4 + qd) * 16384;
#pragma unroll
                for (int ks = 0; ks < 4; ++ks)
#pragma unroll
                    for (int n = 0; n < 2; ++n) sqf[ks][n] = *(const bfx8*)(SQt + (unsigned)((32 * vq_b + 16 * n + fr) * 128 + 32 * ks + 8 * fq)); }
            {
                const int it = wave >> 1;
#pragma unroll
                for (int jj = 0; jj < 2; ++jj) { const int jt = 2 * (wave & 1) + jj;
                    f32x4 a4 = (f32x4){0.f, 0.f, 0.f, 0.f};
                    if (jt <= it) {
#pragma unroll
                        for (int ks = 0; ks < 4; ++ks) { const bfx8 a = *(const LAS bfx8*)(QHl + (16 * it + fr) * QS + 32 * ks + 8 * fq); const bfx8 bt = *(const LAS bfx8*)(KHl + (16 * jt + fr) * QS + 32 * ks + 8 * fq); a4 = MFMA16(bt, a, a4); }
                    }
                    const int ii = 16 * it + fr, j0 = 16 * jt + 4 * fq;
                    const float m0 = (jt <= it && j0 + 0 <= ii) ? a4.x : 0.f, m1 = (jt <= it && j0 + 1 <= ii) ? a4.y : 0.f, m2 = (jt <= it && j0 + 2 <= ii) ? a4.z : 0.f, m3 = (jt <= it && j0 + 3 <= ii) ? a4.w : 0.f;
                    v2u o; o.x = pk2(m0, m1); o.y = pk2(m2, m3); *(LAS v2u*)(AM + ii * TS + j0) = o; }
            }
            __syncthreads();
            {
                const int rh = rh_b, vq = vq_b;
                f32x4 o4[2][2];
#pragma unroll
                for (int mt = 0; mt < 2; ++mt)
#pragma unroll
                    for (int n = 0; n < 2; ++n) o4[mt][n] = (f32x4){0.f, 0.f, 0.f, 0.f};
#pragma unroll
                for (int ks = 0; ks < 4; ++ks)
#pragma unroll
                    for (int mt = 0; mt < 2; ++mt) { const bfx8 a = *(const LAS bfx8*)(QDl + (32 * rh + 16 * mt + fr) * QS + 32 * ks + 8 * fq);
#pragma unroll
                        for (int n = 0; n < 2; ++n) o4[mt][n] = MFMA16(stf[ks][n], a, o4[mt][n]); }
                if (qd) {
#pragma unroll
                    for (int ks = 0; ks < 4; ++ks)
#pragma unroll
                        for (int mt = 0; mt < 2; ++mt) { const bfx8 a = *(const LAS bfx8*)(QD2 + (32 * rh + 16 * mt + fr) * QS + 32 * ks + 8 * fq);
#pragma unroll
                            for (int n = 0; n < 2; ++n) o4[mt][n] = MFMA16(sqf[ks][n], a, o4[mt][n]); } }
#pragma unroll
                for (int ks = 0; ks < 2; ++ks)
#pragma unroll
                    for (int mt = 0; mt < 2; ++mt) { const bfx8 a = *(const LAS bfx8*)(AM + (32 * rh + 16 * mt + fr) * TS + 32 * ks + 8 * fq);
#pragma unroll
                        for (int n = 0; n < 2; ++n) { const bfx8 bt = *(const LAS bfx8*)(VT + (32 * vq + 16 * n + fr) * TS + 32 * ks + 8 * fq); o4[mt][n] = MFMA16(bt, a, o4[mt][n]); } }
#pragma unroll
                for (int mt = 0; mt < 2; ++mt) { const int i = 32 * rh + 16 * mt + fr, tl = dir ? 63 - i : i;
#pragma unroll
                    for (int n = 0; n < 2; ++n) { LAS f32x4* p = (LAS f32x4*)(OS + tl * OSS + 32 * vq + 16 * n + 4 * fq); if (dir == 0) *p = o4[mt][n]; else *p = *p + o4[mt][n]; } }
            }
            __syncthreads();
        }
        {
            const int row = tid >> 3, vseg = tid & 7;
            const LAS f32x4* p = (const LAS f32x4*)(OS + row * OSS + 16 * vseg);
            f32x4 o[4]; float ss = 0.f;
#pragma unroll
            for (int x4 = 0; x4 < 4; ++x4) { o[x4] = p[x4]; ss += (o[x4].x * o[x4].x + o[x4].y * o[x4].y) + (o[x4].z * o[x4].z + o[x4].w * o[x4].w); }
            ss += shx(ss, 1, lane); ss += shx(ss, 2, lane); ss += shx(ss, 4, lane);
            const float r = __builtin_amdgcn_rsqf(ss * (1.f / HK) + EPS);
            float g[8], y[8];
#pragma unroll
            for (int hh = 0; hh < 2; ++hh) { unpack8(hh ? gq1 : gq0, g);
                const f32x4 w0 = *(const f32x4*)(gnw + 16 * vseg + 8 * hh), w1 = *(const f32x4*)(gnw + 16 * vseg + 8 * hh + 4);
                const f32x4 oa = o[2 * hh], ob = o[2 * hh + 1];
                y[0] = oa.x * r * w0.x * g[0]; y[1] = oa.y * r * w0.y * g[1]; y[2] = oa.z * r * w0.z * g[2]; y[3] = oa.w * r * w0.w * g[3];
                y[4] = ob.x * r * w1.x * g[4]; y[5] = ob.y * r * w1.y * g[5]; y[6] = ob.z * r * w1.z * g[6]; y[7] = ob.w * r * w1.w * g[7];
                *(v4u*)(Yo + goff + 8 * hh) = pack8(y); }
        }
    }
}

__device__ __forceinline__ void sconv_phase(const bf16* U, const float* wc, bf16* Y, int gtid, int NT) {
    for (int idx = gtid; idx < M * (D / 8); idx += NT) {
        const int m = idx >> 8, c0 = (idx & 255) * 8, tp = m & (SEQ - 1);
        float w0[8], w1[8], w2[8];
#pragma unroll
        for (int e = 0; e < 8; ++e) { w0[e] = wc[c0 + e]; w1[e] = wc[D + c0 + e]; w2[e] = wc[2 * D + c0 + e]; }
        const bf16* r = U + (size_t)m * N_SC + c0;
        float gb[8], c[8], x[8], z[8];
        unpack8(*(const v4u*)(r), gb); unpack8(*(const v4u*)(r + D), c); unpack8(*(const v4u*)(r + 2 * D), x);
#pragma unroll
        for (int e = 0; e < 8; ++e) z[e] = w1[e] * (c[e] * x[e]);
        if (tp > 0) { unpack8(*(const v4u*)(r - N_SC + D), c); unpack8(*(const v4u*)(r - N_SC + 2 * D), x);
#pragma unroll
            for (int e = 0; e < 8; ++e) z[e] += w0[e] * (c[e] * x[e]); }
        if (tp < SEQ - 1) { unpack8(*(const v4u*)(r + N_SC + D), c); unpack8(*(const v4u*)(r + N_SC + 2 * D), x);
#pragma unroll
            for (int e = 0; e < 8; ++e) z[e] += w2[e] * (c[e] * x[e]); }
#pragma unroll
        for (int e = 0; e < 8; ++e) z[e] *= gb[e];
        *(v4u*)(Y + (size_t)m * D + c0) = pack8(z);
    }
}

__device__ __forceinline__ void ffnact_phase(const bf16* UP, const float* wc, bf16* ACT, int gtid, int NT) {
    constexpr int CB = FF / 8;
    for (int idx = gtid; idx < M * CB; idx += NT) {
        const int m = idx / CB, c0 = (idx - m * CB) * 8, tp = m & (SEQ - 1);
        const bf16* r = UP + (size_t)m * N_FI + c0;
        float g[8], v[8], a[8], b[8];
        unpack8(*(const v4u*)(r), a); unpack8(*(const v4u*)(r + FF), b);
#pragma unroll
        for (int e = 0; e < 8; ++e) { g[e] = wc[N_FI + c0 + e] * a[e]; v[e] = wc[N_FI + FF + c0 + e] * b[e]; }
        if (tp > 0) { unpack8(*(const v4u*)(r - N_FI), a); unpack8(*(const v4u*)(r - N_FI + FF), b);
#pragma unroll
            for (int e = 0; e < 8; ++e) { g[e] += wc[c0 + e] * a[e]; v[e] += wc[FF + c0 + e] * b[e]; } }
        if (tp < SEQ - 1) { unpack8(*(const v4u*)(r + N_FI), a); unpack8(*(const v4u*)(r + N_FI + FF), b);
#pragma unroll
            for (int e = 0; e < 8; ++e) { g[e] += wc[2 * N_FI + c0 + e] * a[e]; v[e] += wc[2 * N_FI + FF + c0 + e] * b[e]; } }
#pragma unroll
        for (int e = 0; e < 8; ++e) g[e] = g[e] * fsig(g[e]) * v[e];
        *(v4u*)(ACT + (size_t)m * FF + c0) = pack8(g);
    }
}

#define XB_TMO      128
#define XB_XCNT(j)  (256  + 64 * (j))
#define XB_XSUB(j)  (1280 + 64 * (j))
#define XB_XGEN(j)  (2304 + 64 * (j))
#define XB_TOP      3328
#define XB_TOPGEN   3392
#define XCD_BAR_WORDS 3456
#define XB_SPIN_CAP (1u << 18)

__device__ __forceinline__ unsigned xb_ld(unsigned* p)              { return __hip_atomic_load(p, __ATOMIC_RELAXED, __HIP_MEMORY_SCOPE_AGENT); }
__device__ __forceinline__ unsigned xb_add(unsigned* p, unsigned v) { return __hip_atomic_fetch_add(p, v, __ATOMIC_RELAXED, __HIP_MEMORY_SCOPE_AGENT); }
__device__ __forceinline__ unsigned xb_xcc_id() { return (unsigned)__builtin_amdgcn_s_getreg((3 << 11) | 20) & 0xFu; }
#define XB_SPIN(cond, bar) do { unsigned _sp = 0; while (cond) { __builtin_amdgcn_s_sleep(1); \
    if ((++_sp & 255u) == 0u) { if (xb_ld(&(bar)[XB_TMO])) break; if (_sp > XB_SPIN_CAP) { atomicAdd(&(bar)[XB_TMO], 1u); break; } } } } while (0)

struct XcdBarrier {
    unsigned* bar; unsigned x;
    volatile LAS unsigned* st;
};

__device__ __forceinline__ XcdBarrier xcd_barrier_post(unsigned* bar, volatile LAS unsigned* st) {
    XcdBarrier b; b.bar = bar; b.x = xb_xcc_id(); b.st = st;
    if (threadIdx.x == 0) (void)xb_add(&bar[XB_XCNT(b.x)], 1u);
    return b;
}
__device__ __forceinline__ void xcd_barrier_complete(unsigned* bar, unsigned x, unsigned& nloc, unsigned& nx) {
    const unsigned G = gridDim.x * gridDim.y * gridDim.z;
    unsigned sum, cnt, mine, sp = 0u;
    for (;;) {
        sum = 0u; cnt = 0u; mine = 0u;
#pragma unroll 1
        for (unsigned j = 0; j < 16; ++j) { const unsigned c = xb_ld(&bar[XB_XCNT(j)]); sum += c; cnt += (c > 0u) ? 1u : 0u; mine = (j == x) ? c : mine; }
        if (sum == G) break;
        __builtin_amdgcn_s_sleep(1);
        if ((++sp & 255u) == 0u) { if (xb_ld(&bar[XB_TMO])) break; if (sp > XB_SPIN_CAP) { atomicAdd(&bar[XB_TMO], 1u); break; } }
    }
    nloc = mine > 0u ? mine : 1u; nx = cnt > 0u ? cnt : 1u;
}

__device__ __forceinline__ void xcd_barrier(const XcdBarrier& b) {
    asm volatile("s_waitcnt vmcnt(0)" ::: "memory");
    __syncthreads();
    if (threadIdx.x == 0) {
        unsigned* bar = b.bar; asm volatile("" : "+s"(bar));
        __builtin_amdgcn_s_waitcnt(0);
        unsigned nloc = b.st[0], nx = b.st[1];
        if (nloc == 0u) { xcd_barrier_complete(bar, b.x, nloc, nx); b.st[0] = nloc; b.st[1] = nx; }
        const unsigned old = xb_add(&bar[XB_XSUB(b.x)], 1u);
        const unsigned gen = old / nloc;
        if (old + 1u == (gen + 1u) * nloc) {
            __builtin_amdgcn_fence(__ATOMIC_RELEASE, "agent");
            asm volatile("s_waitcnt vmcnt(0)" ::: "memory");
            const unsigned og = xb_add(&bar[XB_TOP], 1u);
            const unsigned tg = og / nx;
            if (og + 1u == (tg + 1u) * nx) xb_add(&bar[XB_TOPGEN], 1u);
            else XB_SPIN(xb_ld(&bar[XB_TOPGEN]) == tg, bar);
            __builtin_amdgcn_fence(__ATOMIC_ACQUIRE, "agent");
            xb_add(&bar[XB_XGEN(b.x)], 1u);
            asm volatile("s_waitcnt vmcnt(0)" ::: "memory");
        } else {
            XB_SPIN(xb_ld(&bar[XB_XGEN(b.x)]) == gen, bar);
            __builtin_amdgcn_fence(__ATOMIC_ACQUIRE, "agent");
            asm volatile("s_waitcnt vmcnt(0)" ::: "memory");
        }
    }
    __syncthreads();
}

struct Args { const float* in[15]; float* out; unsigned char* ws; int ph_lo, ph_hi; };
constexpr int N_PHASES = 1 + 2 * 10 + 2 * 8;

template <class Epi>
__device__ __forceinline__ void run_gemm(LAS unsigned char* lds, const bf16* A, const bf16* Bt, int N, int K, const Epi& E, int tid) {
    pg8::Gemm g{A, Bt, M, N, K}; pg8::StaticOrder S; S.init(M, N, (int)gridDim.x, (int)blockIdx.x);
    pg8::gemm_phase<Epi, pg8::StaticOrder, true, true>(lds, g, S, E, tid);
}

__global__ void __launch_bounds__(NTHR, 2) mega_fwd(Args args) {
    extern __shared__ __attribute__((aligned(16))) unsigned char lds_raw[];
    LAS unsigned char* lds = (LAS unsigned char*)lds_raw;
    cg::grid_group grid = cg::this_grid();
    volatile LAS unsigned* bst = (volatile LAS unsigned*)(lds + LDS_BYTES - 64);
    if (threadIdx.x < 16) bst[threadIdx.x] = 0u;
    __syncthreads();
    XcdBarrier xbar = xcd_barrier_post((unsigned*)(args.ws + WS_CTL) + 4096, bst);
    const int lo = args.ph_lo, hi = args.ph_hi;
    int ph = 0;
    const int wave_s = __builtin_amdgcn_readfirstlane(threadIdx.x >> 6);
#define PH_BEGIN if (ph >= lo && ph < hi) { \
    int zz = 0; asm volatile("" : "+v"(zz)); \
    const int lane = (int)__builtin_amdgcn_mbcnt_hi(~0u, __builtin_amdgcn_mbcnt_lo(~0u, (unsigned)zz)), wave = wave_s, tid = wave_s * 64 + lane; \
    const int G = gridDim.x, gw = blockIdx.x * NWAVES + wave, NGW = G * NWAVES, gtid = blockIdx.x * NTHR + tid, NT = G * NTHR; \
    unsigned char* ws = args.ws; asm volatile("" : "+s"(ws)); \
    (void)lane; (void)gw; (void)NGW; (void)gtid; (void)NT;
#define PH_END } ++ph; if (ph - 1 >= lo && ph < hi) { if (ph == 1) grid.sync(); else xcd_barrier(xbar); }
#define x_in args.in[0]
#define hg_w_in args.in[1]
#define hg_w_out args.in[2]
#define hg_gn args.in[3]
#define hg_lb args.in[4]
#define sc_w_in args.in[5]
#define sc_w_conv args.in[6]
#define sc_w_out args.in[7]
#define ff_w_in args.in[8]
#define ff_w_conv args.in[9]
#define ff_w_out args.in[10]
#define n_pre_mix args.in[11]
#define n_post_mix args.in[12]
#define n_pre_ffn args.in[13]
#define n_post_ffn args.in[14]
#define WHGI ((bf16*)(ws + WS_WHGI))
#define WHGO ((bf16*)(ws + WS_WHGO))
#define WSCI ((bf16*)(ws + WS_WSCI))
#define WSCO ((bf16*)(ws + WS_WSCO))
#define WFI ((bf16*)(ws + WS_WFI))
#define WFO ((bf16*)(ws + WS_WFO))
#define X ((bf16*)(ws + WS_X))
#define XN ((bf16*)(ws + WS_XN))
#define MB ((bf16*)(ws + WS_MBUF))
#define U (ws + WS_U)
#define ACT ((bf16*)(ws + WS_ACT))
#define Y ((bf16*)(ws + WS_ACT))
#define Qb ((bf16*)(ws + WS_U + U_Q))
#define Vb ((bf16*)(ws + WS_U + U_V))
#define Gb ((bf16*)(ws + WS_U + U_G))
#define LFf ((float*)(ws + WS_U + U_LFF))
#define LFb ((float*)(ws + WS_U + U_LFB))
#define Of ((float*)(ws + WS_REC))
#define Ob ((float*)(ws + WS_REC + 64 * MiB))

    PH_BEGIN
        LAS float* scr = (LAS float*)(lds + wave * 16384);
        for (int j = 0; j < 2; ++j) {
            transpose_matrix(hg_w_in + (size_t)j * D * N_HG, D, N_HG, WHGI + (size_t)j * N_HG * D, scr, gw, NGW, lane);
            transpose_matrix(hg_w_out + (size_t)j * D * D, D, D, WHGO + (size_t)j * D * D, scr, gw, NGW, lane);
            transpose_matrix(sc_w_in + (size_t)j * D * N_SC, D, N_SC, WSCI + (size_t)j * N_SC * D, scr, gw, NGW, lane);
            transpose_matrix(sc_w_out + (size_t)j * D * D, D, D, WSCO + (size_t)j * D * D, scr, gw, NGW, lane);
        }
        for (int i = 0; i < DEPTH; ++i) {
            transpose_matrix(ff_w_in + (size_t)i * D * N_FI, D, N_FI, WFI + (size_t)i * N_FI * D, scr, gw, NGW, lane);
            transpose_matrix(ff_w_out + (size_t)i * FF * D, FF, D, WFO + (size_t)i * D * FF, scr, gw, NGW, lane);
        }
        rownorm_phase<true>(x_in, nullptr, nullptr, n_pre_mix, X, nullptr, XN, gw, NGW, lane);
    PH_END

    for (int i = 0; i < DEPTH; ++i) {
        const int j = i >> 1;
        if ((i & 1) == 0) {
            PH_BEGIN
                pg8::EpiHgrn E{U, hg_lb, j};
                run_gemm(lds, XN, WHGI + (size_t)j * N_HG * D, N_HG, D, E, tid);
            PH_END
            PH_BEGIN
                rec_pass1(lds, Vb, LFf, LFb, (bf16*)(ws + WS_REC + REC_PT), (float*)(ws + WS_REC + REC_ALOG), (float*)(ws + WS_REC + REC_PEND), (float*)(ws + WS_REC + REC_AEND), tid);
            PH_END
            PH_BEGIN
                rec_pass2((const float*)(ws + WS_REC + REC_PEND), (const float*)(ws + WS_REC + REC_AEND), (bf16*)(ws + WS_REC + REC_SQ), gtid, NT);
            PH_END
            PH_BEGIN
                rec_pass3(lds, Qb, Vb, Gb, LFf, LFb, (const bf16*)(ws + WS_REC + REC_PT), (const float*)(ws + WS_REC + REC_ALOG), (const bf16*)(ws + WS_REC + REC_SQ), hg_gn + (size_t)j * HK, Y, tid);
            PH_END
            PH_BEGIN
                pg8::EpiBf16 E{MB, D};
                run_gemm(lds, Y, WHGO + (size_t)j * D * D, D, D, E, tid);
            PH_END
        } else {
            PH_BEGIN
                pg8::EpiBf16 E{(bf16*)U, N_SC};
                run_gemm(lds, XN, WSCI + (size_t)j * N_SC * D, N_SC, D, E, tid);
            PH_END
            PH_BEGIN
                sconv_phase((const bf16*)U, sc_w_conv + (size_t)j * 3 * D, Y, gtid, NT);
            PH_END
            PH_BEGIN
                pg8::EpiBf16 E{MB, D};
                run_gemm(lds, Y, WSCO + (size_t)j * D * D, D, D, E, tid);
            PH_END
        }
        PH_BEGIN
            rownorm_phase<false>(X, MB, n_post_mix + (size_t)i * D, n_pre_ffn + (size_t)i * D, X, nullptr, XN, gw, NGW, lane);
        PH_END
        PH_BEGIN
            pg8::EpiBf16 E{(bf16*)U, N_FI};
            run_gemm(lds, XN, WFI + (size_t)i * N_FI * D, N_FI, D, E, tid);
        PH_END
        PH_BEGIN
            ffnact_phase((const bf16*)U, ff_w_conv + (size_t)i * 3 * N_FI, ACT, gtid, NT);
        PH_END
        PH_BEGIN
            pg8::EpiBf16 E{MB, D};
            run_gemm(lds, ACT, WFO + (size_t)i * D * FF, D, FF, E, tid);
        PH_END
        PH_BEGIN
            if (i == DEPTH - 1) rownorm_phase<false>(X, MB, n_post_ffn + (size_t)i * D, nullptr, nullptr, args.out, nullptr, gw, NGW, lane);
            else rownorm_phase<false>(X, MB, n_post_ffn + (size_t)i * D, n_pre_mix + (size_t)(i + 1) * D, X, nullptr, XN, gw, NGW, lane);
        PH_END
    }
#undef PH_BEGIN
#undef PH_END
#undef X
#undef Y
#undef U
}

#ifndef MK_MULTI
#define MK_MULTI 0
#endif
extern "C" void kernel_launch(void* const* d_in, const int* in_sizes, int n_in, void* d_out, int out_size, void* d_ws, size_t ws_size, hipStream_t stream) {
    static int grid = 0;
    if (grid == 0) {
        if (n_in != 15 || out_size != M * D || ws_size < WS_END) { fprintf(stderr, "kernel_launch: unexpected shapes (n_in %d out %d ws %zu)\n", n_in, out_size, ws_size); grid = -1; return; }
        int dev = 0, cus = 0, per_cu = 0;
        hipGetDevice(&dev); hipDeviceGetAttribute(&cus, hipDeviceAttributeMultiprocessorCount, dev);
        if (hipFuncSetAttribute((const void*)mega_fwd, hipFuncAttributeMaxDynamicSharedMemorySize, LDS_BYTES) != hipSuccess) { fprintf(stderr, "hipFuncSetAttribute failed\n"); grid = -1; return; }
        if (hipOccupancyMaxActiveBlocksPerMultiprocessor(&per_cu, (const void*)mega_fwd, NTHR, LDS_BYTES) != hipSuccess || per_cu < 1) { fprintf(stderr, "occupancy query: %d\n", per_cu); per_cu = 1; }
        (void)hipGetLastError();
        grid = cus * 1;
    }
    if (grid < 0) return;
    if (hipMemsetAsync((char*)d_ws + WS_CTL, 0, 65536, stream) != hipSuccess) { fprintf(stderr, "memset failed\n"); return; }
    Args a{};
    for (int i = 0; i < 15; ++i) a.in[i] = (const float*)d_in[i];
    a.out = (float*)d_out; a.ws = (unsigned char*)d_ws;
#if MK_MULTI
    for (int p = 0; p < N_PHASES; ++p) { a.ph_lo = p; a.ph_hi = p + 1; hipLaunchKernelGGL(mega_fwd, dim3(grid), dim3(NTHR), LDS_BYTES, stream, a); }
#else
    a.ph_lo = 0; a.ph_hi = N_PHASES;
    void* kargs[] = {&a};
    hipError_t e = hipLaunchCooperativeKernel((const void*)mega_fwd, dim3(grid), dim3(NTHR), kargs, LDS_BYTES, stream);
    if (e != hipSuccess) fprintf(stderr, "cooperative launch failed: %s (grid %d)\n", hipGetErrorString(e), grid);
#endif
}
```
